# Optimizing an MI355X kernel written in HIP

```python
import jax, jax.numpy as jnp
from jax import lax
import numpy as np

D_MODEL = 1024
BATCH = 16
SEQ = 2048
DEPTH = 4

N_MIXERS = 2
N_LAYERS_A = (DEPTH + N_MIXERS - 1) // N_MIXERS
N_LAYERS_B = DEPTH // N_MIXERS
CHUNK = 128
SGU_HEADS = 8
SGU_WIDTH = 2 * D_MODEL
SGU_HEAD_DIM = SGU_WIDTH // SGU_HEADS
POOL_WINDOWS = (2, 4, 8, 16)
POOL_GROUPS = len(POOL_WINDOWS)
POOL_WIDTH = D_MODEL
POOL_GROUP_DIM = POOL_WIDTH // POOL_GROUPS
N_EXPERT_GROUPS = 4
EXPERTS_PER_GROUP = 8
N_EXPERTS = N_EXPERT_GROUPS * EXPERTS_PER_GROUP
TOP_K = 2
D_EXPERT = D_MODEL // 2
EXPERT_BLOCK = 128
EPS = 1e-6

kernel_name = "hybrid_sgu_pool_hmoe_encoder"


def rmsnorm(x, g):
    xf = x.astype(jnp.float32)
    y = xf * lax.rsqrt(jnp.mean(xf * xf, axis=-1, keepdims=True) + EPS)
    return (y * g.astype(jnp.float32)).astype(x.dtype)


def sgu_mixer(h, w_in, b_in, g_v, w_s, b_s, w_out):
    bsz, seq, _ = h.shape
    z = jax.nn.gelu(h @ w_in + b_in, approximate=False)
    u, v = jnp.split(z, 2, axis=-1)
    v = rmsnorm(v, g_v)
    v = v.reshape(bsz, seq // CHUNK, CHUNK, SGU_HEADS, SGU_HEAD_DIM)
    sv = jnp.einsum('hts,bcshd->bcthd', w_s, v) + b_s.T[:, :, None]
    y = u * sv.reshape(bsz, seq, SGU_WIDTH)
    return y @ w_out


def pool_mixer(h, w_in, w_group, scale, w_out):
    bsz, seq, _ = h.shape
    v = h @ w_in
    csum = jnp.cumsum(jnp.pad(v.astype(jnp.float32), ((0, 0), (1, 0), (0, 0))), axis=1)
    pos = jnp.arange(seq)
    outs = []
    for g, w in enumerate(POOL_WINDOWS):
        sl = slice(g * POOL_GROUP_DIM, (g + 1) * POOL_GROUP_DIM)
        lo = jnp.clip(pos - w // 2, 0, seq)
        hi = jnp.clip(pos - w // 2 + w, 0, seq)
        cg = csum[:, :, sl]
        cnt = (hi - lo).astype(jnp.float32)[None, :, None]
        mean = (jnp.take(cg, hi, axis=1) - jnp.take(cg, lo, axis=1)) / cnt
        d = mean.astype(v.dtype) - v[..., sl]
        outs.append(d @ w_group[g])
    y = jnp.concatenate(outs, axis=-1) * scale
    return y @ w_out


def hierarchical_moe(h, rg_w, rg_b, re_w, re_b, w_gate, w_up, w_down):
    bsz, seq, d = h.shape
    n_tok = bsz * seq
    xt = h.reshape(n_tok, d)
    xf = xt.astype(jnp.float32)
    g_logits = xf @ rg_w.astype(jnp.float32) + rg_b.astype(jnp.float32)
    g_prob = jax.nn.softmax(g_logits, axis=-1)
    g_w, g_idx = lax.top_k(g_prob, 1)
    e_logits = (xf @ re_w.astype(jnp.float32) + re_b.astype(jnp.float32)).reshape(
        n_tok, N_EXPERT_GROUPS, EXPERTS_PER_GROUP)
    e_sel = jnp.take_along_axis(e_logits, g_idx[:, :, None], axis=1)[:, 0]
    e_prob = jax.nn.softmax(e_sel, axis=-1)
    e_w, e_idx = lax.top_k(e_prob, TOP_K)
    e_w = e_w / jnp.sum(e_w, axis=-1, keepdims=True)
    gate = g_w * e_w
    expert_id = g_idx * EXPERTS_PER_GROUP + e_idx

    n_assign = n_tok * TOP_K
    flat_e = expert_id.reshape(-1)
    order = jnp.argsort(flat_e)
    sorted_e = flat_e[order]
    tok = order // TOP_K
    counts = jnp.bincount(flat_e, length=N_EXPERTS)
    starts = jnp.cumsum(counts) - counts
    padded = ((counts + EXPERT_BLOCK - 1) // EXPERT_BLOCK) * EXPERT_BLOCK
    pend = jnp.cumsum(padded)
    pstart = pend - padded
    dest = pstart[sorted_e] + (jnp.arange(n_assign) - starts[sorted_e])
    n_blocks = -(-n_assign // EXPERT_BLOCK) + N_EXPERTS
    buf = jnp.zeros((n_blocks * EXPERT_BLOCK, d), xt.dtype).at[dest].set(xt[tok])
    block_expert = jnp.minimum(
        jnp.searchsorted(pend, jnp.arange(n_blocks) * EXPERT_BLOCK, side='right'), N_EXPERTS - 1)

    def expert_block(args):
        xb, e = args
        hid = jax.nn.silu(xb @ w_gate[e]) * (xb @ w_up[e])
        return hid @ w_down[e]

    yb = lax.map(expert_block, (buf.reshape(n_blocks, EXPERT_BLOCK, d), block_expert))
    y_sorted = yb.reshape(n_blocks * EXPERT_BLOCK, d)[dest]
    w_sorted = gate.reshape(-1)[order].astype(y_sorted.dtype)
    out = jax.ops.segment_sum(y_sorted * w_sorted[:, None], tok, num_segments=n_tok)
    return out.reshape(bsz, seq, d)


def setup_inputs(seed: int = 0) -> dict:
    key = jax.random.key(seed)
    ks = jax.random.split(key, 21)

    def nrm(k, shape, scale):
        return jax.random.normal(k, shape, jnp.float32) * scale

    D, F, E = D_MODEL, D_EXPERT, N_EXPERTS
    return {
        "x": nrm(ks[0], (BATCH, SEQ, D), 1.0),
        "norm_mix_g": 1.0 + nrm(ks[1], (DEPTH, D), 0.02),
        "norm_ffn_g": 1.0 + nrm(ks[2], (DEPTH, D), 0.02),
        "a_w_in": nrm(ks[3], (N_LAYERS_A, D, 2 * SGU_WIDTH), D ** -0.5),
        "a_b_in": nrm(ks[4], (N_LAYERS_A, 2 * SGU_WIDTH), 0.02),
        "a_norm_v": 1.0 + nrm(ks[5], (N_LAYERS_A, SGU_WIDTH), 0.02),
        "a_w_spatial": nrm(ks[6], (N_LAYERS_A, SGU_HEADS, CHUNK, CHUNK), CHUNK ** -0.5),
        "a_b_spatial": 1.0 + nrm(ks[7], (N_LAYERS_A, SGU_HEADS, CHUNK), 0.02),
        "a_w_out": nrm(ks[8], (N_LAYERS_A, SGU_WIDTH, D), SGU_WIDTH ** -0.5),
        "b_w_in": nrm(ks[9], (N_LAYERS_B, D, POOL_WIDTH), D ** -0.5),
        "b_w_group": nrm(ks[10], (N_LAYERS_B, POOL_GROUPS, POOL_GROUP_DIM, POOL_GROUP_DIM),
                         POOL_GROUP_DIM ** -0.5),
        "b_scale": 1.0 + nrm(ks[11], (N_LAYERS_B, POOL_WIDTH), 0.02),
        "b_w_out": nrm(ks[12], (N_LAYERS_B, POOL_WIDTH, D), POOL_WIDTH ** -0.5),
        "router_group_w": nrm(ks[13], (DEPTH, D, N_EXPERT_GROUPS), D ** -0.5),
        "router_group_b": nrm(ks[14], (DEPTH, N_EXPERT_GROUPS), 0.01),
        "router_expert_w": nrm(ks[15], (DEPTH, D, E), D ** -0.5),
        "router_expert_b": nrm(ks[16], (DEPTH, E), 0.01),
        "w_gate": nrm(ks[17], (DEPTH, E, D, F), D ** -0.5),
        "w_up": nrm(ks[18], (DEPTH, E, D, F), D ** -0.5),
        "w_down": nrm(ks[19], (DEPTH, E, F, D), F ** -0.5),
        "final_norm_g": 1.0 + nrm(ks[20], (D,), 0.02),
    }


def reference(x, norm_mix_g, norm_ffn_g, a_w_in, a_b_in, a_norm_v, a_w_spatial, a_b_spatial,
              a_w_out, b_w_in, b_w_group, b_scale, b_w_out, router_group_w, router_group_b,
              router_expert_w, router_expert_b, w_gate, w_up, w_down, final_norm_g):
    for i in range(DEPTH):
        h = rmsnorm(x, norm_mix_g[i])
        j = i // N_MIXERS
        if i % N_MIXERS == 0:
            x = x + sgu_mixer(h, a_w_in[j], a_b_in[j], a_norm_v[j], a_w_spatial[j],
                              a_b_spatial[j], a_w_out[j])
        else:
            x = x + pool_mixer(h, b_w_in[j], b_w_group[j], b_scale[j], b_w_out[j])
        h = rmsnorm(x, norm_ffn_g[i])
        x = x + hierarchical_moe(h, router_group_w[i], router_group_b[i], router_expert_w[i],
                                 router_expert_b[i], w_gate[i], w_up[i], w_down[i])
    return rmsnorm(x, final_norm_g)
```

```cpp
#include <hip/hip_runtime.h>
#include <hip/hip_cooperative_groups.h>
#include <cstdio>
#include <cstdint>
#include <cstring>
namespace cg = cooperative_groups;

#ifndef MK_SINGLE
#define MK_SINGLE 1
#endif

#ifndef MK_CG_SYNC
#define MK_CG_SYNC 0
#endif

#define LAS __attribute__((address_space(3)))
typedef unsigned short bf16_t;
typedef short bf16x8 __attribute__((ext_vector_type(8)));
typedef short s16x4 __attribute__((ext_vector_type(4)));
typedef float f32x4 __attribute__((ext_vector_type(4)));
typedef float f32x2 __attribute__((ext_vector_type(2)));
typedef unsigned u32x4 __attribute__((ext_vector_type(4)));
typedef unsigned u32x2 __attribute__((ext_vector_type(2)));
typedef int i32x4 __attribute__((ext_vector_type(4)));
typedef __bf16 bf16x2_t __attribute__((ext_vector_type(2)));

constexpr int T_ = 32768, DM = 1024, SEQ = 2048;
constexpr int NTHREADS = 512;
constexpr float EPS = 1e-6f;
constexpr int LIST_CAP = 32768;
constexpr int MAX_TILES = 288;

constexpr size_t CTL_BYTES = 65536;
constexpr size_t OFF_CTL = 0;
constexpr size_t OFF_VSS = OFF_CTL + CTL_BYTES;
constexpr size_t OFF_XSS = OFF_VSS + (size_t)2 * T_ * 32 * 4;
constexpr size_t OFF_LIST = OFF_XSS + (size_t)T_ * 16 * 4;
constexpr size_t OFF_SLOT = OFF_LIST + (size_t)32 * LIST_CAP * 4;
constexpr size_t OFF_GATE = OFF_SLOT + (size_t)T_ * 16;
constexpr size_t OFF_WAIN = OFF_GATE + (size_t)T_ * 8;
constexpr size_t OFF_WAOUT = OFF_WAIN + (size_t)2 * 4096 * 1024 * 2;
constexpr size_t OFF_WBIN = OFF_WAOUT + (size_t)2 * 1024 * 2048 * 2;
constexpr size_t OFF_WBG = OFF_WBIN + (size_t)2 * 1024 * 1024 * 2;
constexpr size_t OFF_WBOUT = OFF_WBG + (size_t)2 * 4 * 256 * 256 * 2;
constexpr size_t OFF_WBT = OFF_WBOUT + (size_t)2 * 1024 * 1024 * 2;
constexpr size_t OFF_WGU = OFF_WBT + (size_t)2 * 1024 * 1024 * 2;
constexpr size_t OFF_WDN = OFF_WGU + (size_t)128 * 1024 * 1024 * 2;
constexpr size_t OFF_H = OFF_WDN + (size_t)128 * 1024 * 512 * 2;
constexpr size_t OFF_Z = OFF_H + (size_t)T_ * 1024 * 2;
constexpr size_t OFF_YS = OFF_Z + (size_t)T_ * 4096 * 2;
constexpr size_t OFF_XB = OFF_YS + (size_t)T_ * 2048 * 2;
constexpr size_t OFF_RSTD = OFF_XB + (size_t)T_ * 1024 * 2;
constexpr size_t OFF_RSS = OFF_RSTD + (size_t)T_ * 4;
constexpr size_t WS_END = OFF_RSS + (size_t)32 * LIST_CAP * 4;
constexpr size_t HID_BYTES = (size_t)MAX_TILES * 256 * 512 * 2;
constexpr int CW_CNT = 4096;

constexpr int STAGE_BYTES = 131072;
constexpr int LDS_MISC = 148608;
constexpr int LDS_BYTES = 148608 + 1024;

struct Params {
    const float* in[21];
    float* X;
    unsigned char* ws;
};
typedef const __attribute__((address_space(4))) Params* KP;

__device__ __forceinline__ unsigned pk_bf16(float lo, float hi) { f32x2 v = {lo, hi}; bf16x2_t b = __builtin_convertvector(v, bf16x2_t); return __builtin_bit_cast(unsigned, b); }
__device__ __forceinline__ float bf_lo(unsigned w) { return __uint_as_float(w << 16); }
__device__ __forceinline__ float bf_hi(unsigned w) { return __uint_as_float(w & 0xffff0000u); }
__device__ __forceinline__ float wave_sum(float v) {
#pragma unroll
    for (int o = 32; o >= 1; o >>= 1) v += __shfl_xor(v, o);
    return v;
}
__device__ __forceinline__ f32x2 gelu_pk(f32x2 v) {
    f32x2 c; c.x = __builtin_amdgcn_fmed3f(v.x, -4.5f, 4.5f); c.y = __builtin_amdgcn_fmed3f(v.y, -4.5f, 4.5f);
    const f32x2 s = c * c;
    f32x2 q = s * (-1.314259884e-12f) + 1.615359483e-10f;
    q = q * s + (-8.862621216e-09f); q = q * s + 2.885190317e-07f; q = q * s + (-6.266685043e-06f); q = q * s + 9.706125547e-05f;
    q = q * s + (-1.118662168e-03f); q = q * s + 9.821903153e-03f; q = q * s + (-6.632139887e-02f); q = q * s + 3.988761390e-01f;
    const f32x2 ph = c * q + 0.5f;
    return v * ph;
}
__device__ __forceinline__ float silu_f(float x) { return x * __builtin_amdgcn_rcpf(1.0f + __expf(-x)); }

__device__ __forceinline__ int tid_opaque() { int t = threadIdx.x; asm volatile("" : "+v"(t)); return t; }

__device__ __forceinline__ size_t zoff(int row, int col) { return ((size_t)((row >> 7) * 16 + (col >> 8)) * 128 + (row & 127)) * 256 + (col & 255); }

constexpr int BM = 256, BK = 64, HALF = 128, HTB = HALF * BK * 2, NXCD = 8, WGM = 8;

__device__ __forceinline__ int lds_byte(int r, int c) { const int st = (r >> 4) * 2 + (c >> 5), rr = r & 15, cc = c & 31, ob = rr * 64 + cc * 2; return st * 1024 + (ob ^ (((ob >> 9) & 1) << 5)); }
__device__ __forceinline__ void stage_rc(int b, int& R, int& C) { const int st = b / 1024, sb = b % 1024, swz = sb ^ (((sb >> 9) & 1) << 5); R = (st >> 1) * 16 + swz / 64; C = (st & 1) * 32 + (swz % 64) / 2; }
__device__ __forceinline__ int perm32(int rho) { const int n = rho >> 4, i = rho & 15; return 8 * (i >> 2) + 4 * n + (i & 3); }

struct Unit { int orow, ocol; unsigned aoff, boff; int gbase, gcnt; };
struct GemmDesc { const bf16_t* A; const bf16_t* Bt; int lda, ldb, K; const int* list; };

struct DenseSched {
    int nM, nN, nwg, G, c; unsigned a_pm, a_pn, b_pn;
    __device__ void init(int M, int N, int G_, int c_, int lda, int ldb, unsigned a_pn_bytes) { nM = M / BM; nN = N / BM; nwg = nM * nN; G = G_; c = c_; a_pm = (unsigned)BM * lda * 2; a_pn = a_pn_bytes; b_pn = (unsigned)BM * ldb * 2; }
    __device__ __forceinline__ bool next(int i, Unit& u) const {
        const long L = (long)i * G + c; if (L >= nwg) return false;
        int wgid = (int)L; { const int q = nwg / NXCD, r = nwg % NXCD, xcd = wgid % NXCD, off = wgid / NXCD; wgid = (xcd < r ? xcd * (q + 1) : r * (q + 1) + (xcd - r) * q) + off; }
        const int nig = WGM * nN, gid = wgid / nig, fm = gid * WGM, gsz = (nM - fm) < WGM ? (nM - fm) : WGM;
        const int pm = fm + ((wgid % nig) % gsz), pn = (wgid % nig) / gsz;
        u.orow = pm * BM; u.ocol = pn * BM; u.aoff = pm * a_pm + pn * a_pn; u.boff = pn * b_pn; u.gbase = 0; u.gcnt = 0; return true;
    }
};
struct FoldSched {
    int G, c;
    __device__ __forceinline__ bool next(int i, Unit& u) const {
        const int L = i * G + c; if (L >= 32) return false;
        const int jl = L >> 4, g = (L >> 2) & 3, pm = L & 3;
        u.orow = jl * 1024 + pm * 256; u.ocol = g * 256; u.aoff = (unsigned)((jl * 1024 + pm * 256) * 1024 + g * 256) * 2u; u.boff = (unsigned)(jl * 4 + g) * 131072u; u.gbase = 0; u.gcnt = 0; return true;
    }
};
struct MoeSched {
    int G, c, ng, x, slot, nslots, mode;
    int cnt_v, tiles_v, tb_v;
    __device__ void init(const unsigned* cnt, int G_, int c_, int mode_) {
        G = G_; c = c_; mode = mode_; ng = (G % 8 == 0) ? 8 : 1; x = c % ng; slot = c / ng; nslots = G / ng;
        const int lane = tid_opaque() & 63;
        int cn = 0; if (lane < 32) cn = (int)__hip_atomic_load(cnt + lane * 16, __ATOMIC_RELAXED, __HIP_MEMORY_SCOPE_AGENT);
        const int tl = (cn + 255) >> 8; int v = tl;
#pragma unroll
        for (int d = 1; d < 32; d <<= 1) { const int t = __shfl_up(v, d); if (lane >= d) v += t; }
        cnt_v = cn; tiles_v = tl; tb_v = v - tl;
    }
    __device__ __forceinline__ bool next(int i, Unit& u) const {
        int v = i * nslots + slot;
        for (int e = x; e < 32; e += ng) {
            const int te = __builtin_amdgcn_readlane(tiles_v, e), ne = te * 4;
            if (v < ne) {
                const int jt = v % te, pn = v / te, tb = __builtin_amdgcn_readlane(tb_v, e), cn = __builtin_amdgcn_readlane(cnt_v, e);
                u.orow = (tb + jt) * 256; u.ocol = pn * 256;
                if (mode == 0) { u.aoff = 0; u.boff = (unsigned)(e * 1024 + pn * 256) * 2048u; u.gbase = e * LIST_CAP + jt * 256; u.gcnt = cn - jt * 256; }
                else { u.aoff = (unsigned)(tb + jt) * 262144u; u.boff = (unsigned)(e * 1024 + pn * 256) * 1024u; u.gbase = 0; u.gcnt = 0; }
                return true;
            }
            v -= ne;
        }
        return false;
    }
};

struct EpiAin {
    static constexpr bool PERM = true;
    bf16_t* Z; const float* bias; float* vss; const float* rstd;
    __device__ __forceinline__ void operator()(const f32x4 (&acc)[2][2][4][2], const Unit& u, int wr, int wc, int fr, int fq) const {
        const int row0 = u.orow + wr * 64 + fr, col0 = u.ocol + wc * 32 + 8 * fq; const bool vt = u.ocol >= 2048;
        f32x4 bv[2][2];
#pragma unroll
        for (int bj = 0; bj < 2; ++bj)
#pragma unroll
            for (int n = 0; n < 2; ++n) bv[bj][n] = *(const f32x4*)(bias + col0 + bj * HALF + 4 * n);
        float rsv[2][4];
#pragma unroll
        for (int ai = 0; ai < 2; ++ai)
#pragma unroll
            for (int m = 0; m < 4; ++m) rsv[ai][m] = rstd[row0 + ai * HALF + m * 16];
        if (vt) {
#pragma unroll
            for (int ai = 0; ai < 2; ++ai)
#pragma unroll
                for (int m = 0; m < 4; ++m) { const int row = row0 + ai * HALF + m * 16; bf16_t* rowp = Z + zoff(row, col0); float ss = 0.f; const float rs = rsv[ai][m];
#pragma unroll
                    for (int bj = 0; bj < 2; ++bj) { f32x4 v0 = acc[ai][bj][m][0] * rs + bv[bj][0], v1 = acc[ai][bj][m][1] * rs + bv[bj][1];
                        const f32x2 a = gelu_pk((f32x2){v0[0], v0[1]}), b = gelu_pk((f32x2){v0[2], v0[3]}), c = gelu_pk((f32x2){v1[0], v1[1]}), d = gelu_pk((f32x2){v1[2], v1[3]});
                        ss += (a.x * a.x + a.y * a.y) + (b.x * b.x + b.y * b.y) + (c.x * c.x + c.y * c.y) + (d.x * d.x + d.y * d.y);
                        u32x4 w; w.x = pk_bf16(a.x, a.y); w.y = pk_bf16(b.x, b.y); w.z = pk_bf16(c.x, c.y); w.w = pk_bf16(d.x, d.y);
                        *(u32x4*)(rowp + bj * HALF) = w; }
                    ss += __shfl_xor(ss, 16); ss += __shfl_xor(ss, 32); if (fq == 0) vss[(size_t)row * 32 + (((u.ocol - 2048) >> 8) * 4 + wc)] = ss; }
        } else {
#pragma unroll
            for (int ai = 0; ai < 2; ++ai)
#pragma unroll
                for (int m = 0; m < 4; ++m) { bf16_t* rowp = Z + zoff(row0 + ai * HALF + m * 16, col0); const float rs = rsv[ai][m];
#pragma unroll
                    for (int bj = 0; bj < 2; ++bj) { const f32x4 v0 = acc[ai][bj][m][0] * rs + bv[bj][0], v1 = acc[ai][bj][m][1] * rs + bv[bj][1];
                        u32x4 w; w.x = pk_bf16(v0[0], v0[1]); w.y = pk_bf16(v0[2], v0[3]); w.z = pk_bf16(v1[0], v1[1]); w.w = pk_bf16(v1[2], v1[3]);
                        *(u32x4*)(rowp + bj * HALF) = w; } }
        }
    }
};
struct EpiResid {
    static constexpr bool PERM = true;
    bf16_t* XB; float* xss;
    __device__ __forceinline__ void operator()(const f32x4 (&acc)[2][2][4][2], const Unit& u, int wr, int wc, int fr, int fq) const {
        const int row0 = u.orow + wr * 64 + fr, col0 = u.ocol + wc * 32 + 8 * fq;
#pragma unroll
        for (int ai = 0; ai < 2; ++ai) {
            __builtin_amdgcn_sched_barrier(0);
            u32x4 res[4][2];
#pragma unroll
            for (int m = 0; m < 4; ++m) { const bf16_t* inp = XB + (size_t)(row0 + ai * HALF + m * 16) * 1024 + col0;
#pragma unroll
                for (int bj = 0; bj < 2; ++bj) res[m][bj] = *(const u32x4*)(inp + bj * HALF); }
#pragma unroll
            for (int m = 0; m < 4; ++m) { const int row = row0 + ai * HALF + m * 16; bf16_t* rowp = XB + (size_t)row * 1024 + col0; float ss = 0.f;
#pragma unroll
                for (int bj = 0; bj < 2; ++bj) { const u32x4 r = res[m][bj]; const f32x4 a0 = acc[ai][bj][m][0], a1 = acc[ai][bj][m][1];
                    u32x4 w; w.x = pk_bf16(bf_lo(r.x) + a0[0], bf_hi(r.x) + a0[1]); w.y = pk_bf16(bf_lo(r.y) + a0[2], bf_hi(r.y) + a0[3]);
                    w.z = pk_bf16(bf_lo(r.z) + a1[0], bf_hi(r.z) + a1[1]); w.w = pk_bf16(bf_lo(r.w) + a1[2], bf_hi(r.w) + a1[3]);
                    *(u32x4*)(rowp + bj * HALF) = w;
                    const float v0 = bf_lo(w.x), v1 = bf_hi(w.x), v2 = bf_lo(w.y), v3 = bf_hi(w.y), v4 = bf_lo(w.z), v5 = bf_hi(w.z), v6 = bf_lo(w.w), v7 = bf_hi(w.w);
                    ss += ((v0 * v0 + v1 * v1) + (v2 * v2 + v3 * v3)) + ((v4 * v4 + v5 * v5) + (v6 * v6 + v7 * v7)); }
                ss += __shfl_xor(ss, 16); ss += __shfl_xor(ss, 32);
                if (fq == 0) xss[(size_t)row * 16 + (u.ocol >> 8) * 4 + wc] = ss; }
        }
    }
};
struct EpiBf {
    static constexpr bool PERM = true;
    bf16_t* O; int ldc; const float* scale; const float* rowscale;
    __device__ __forceinline__ void operator()(const f32x4 (&acc)[2][2][4][2], const Unit& u, int wr, int wc, int fr, int fq) const {
        const int row0 = u.orow + wr * 64 + fr, col0 = u.ocol + wc * 32 + 8 * fq;
        float rsv[2][4];
#pragma unroll
        for (int ai = 0; ai < 2; ++ai)
#pragma unroll
            for (int m = 0; m < 4; ++m) rsv[ai][m] = rowscale ? rowscale[row0 + ai * HALF + m * 16] : 1.0f;
#pragma unroll
        for (int ai = 0; ai < 2; ++ai)
#pragma unroll
            for (int m = 0; m < 4; ++m) { bf16_t* rowp = O + (size_t)(row0 + ai * HALF + m * 16) * ldc + col0;
                asm volatile("" ::: "memory");
                const float rs = rsv[ai][m];
#pragma unroll
                for (int bj = 0; bj < 2; ++bj) { f32x4 v0 = acc[ai][bj][m][0] * rs, v1 = acc[ai][bj][m][1] * rs;
                    if (scale) { v0 = v0 * *(const f32x4*)(scale + col0 + bj * HALF); v1 = v1 * *(const f32x4*)(scale + col0 + bj * HALF + 4); }
                    u32x4 w; w.x = pk_bf16(v0[0], v0[1]); w.y = pk_bf16(v0[2], v0[3]); w.z = pk_bf16(v1[0], v1[1]); w.w = pk_bf16(v1[2], v1[3]);
                    *(u32x4*)(rowp + bj * HALF) = w; } }
    }
};
struct EpiSwiglu {
    static constexpr bool PERM = true;
    bf16_t* HID; const float* rss;
    __device__ __forceinline__ void operator()(const f32x4 (&acc)[2][2][4][2], const Unit& u, int wr, int wc, int fr, int fq) const {
        const int row0 = u.orow + wr * 64 + fr, col0 = (u.ocol >> 1) + wc * 32 + 8 * fq, ri0 = wr * 64 + fr;
        float rs[2][4];
#pragma unroll
        for (int ai = 0; ai < 2; ++ai)
#pragma unroll
            for (int m = 0; m < 4; ++m) { const int idx = ri0 + ai * HALF + m * 16; rs[ai][m] = idx < u.gcnt ? rss[u.gbase + idx] : 0.f; }
#pragma unroll
        for (int ai = 0; ai < 2; ++ai)
#pragma unroll
            for (int m = 0; m < 4; ++m) { bf16_t* rowp = HID + (size_t)(row0 + ai * HALF + m * 16) * 512 + col0; const float r = rs[ai][m];
                const f32x4 g0 = acc[ai][0][m][0] * r, g1 = acc[ai][0][m][1] * r, u0 = acc[ai][1][m][0] * r, u1 = acc[ai][1][m][1] * r;
                u32x4 w; w.x = pk_bf16(silu_f(g0[0]) * u0[0], silu_f(g0[1]) * u0[1]); w.y = pk_bf16(silu_f(g0[2]) * u0[2], silu_f(g0[3]) * u0[3]);
                w.z = pk_bf16(silu_f(g1[0]) * u1[0], silu_f(g1[1]) * u1[1]); w.w = pk_bf16(silu_f(g1[2]) * u1[2], silu_f(g1[3]) * u1[3]);
                *(u32x4*)rowp = w; }
    }
};

template <class Epi, class Sched, bool GATHER>
__device__ __forceinline__ void gemm_phase(LAS unsigned char* lds, const GemmDesc g, const Sched& S, const Epi& E) {
    const int tid = tid_opaque(), wid = __builtin_amdgcn_readfirstlane(tid >> 6), lane = tid & 63, wr = wid >> 2, wc = wid & 3, fr = lane & 15, fq = lane >> 4;
    const int K = g.K, nt = K / BK;
    unsigned voffB[2];
#pragma unroll
    for (int i = 0; i < 2; ++i) { int R, C; stage_rc(tid * 16 + i * 8192, R, C); const int Rb = Epi::PERM ? ((R & ~31) + perm32(R & 31)) : R; voffB[i] = (unsigned)(Rb * g.ldb + C) * 2u; }
    const size_t kstep = (size_t)(BK * 2);
    const size_t hstepB = (size_t)HALF * g.ldb * 2;
    const unsigned ldsw = (unsigned)wid * 1024u;
    const int aoff = lds_byte(wr * 64 + fr, fq * 8), boff = lds_byte(wc * 32 + fr, fq * 8);
    auto setA = [&](unsigned (&v)[2][2], const Unit& u) {
#pragma unroll
        for (int i = 0; i < 2; ++i) { int R, C; stage_rc(tid * 16 + i * 8192, R, C);
#pragma unroll
            for (int h = 0; h < 2; ++h) { const int idx = h * HALF + R;
                if constexpr (GATHER) { const int tok = idx < u.gcnt ? g.list[u.gbase + idx] : 0; v[h][i] = ((unsigned)tok * (unsigned)g.lda + (unsigned)C) * 2u; }
                else v[h][i] = ((unsigned)idx * (unsigned)g.lda + (unsigned)C) * 2u; } }
    };
#define PG_SA(b, h) (((b) * 2 + (h)) * HTB)
#define PG_SB(b, h) ((4 + (b) * 2 + (h)) * HTB)
#define PG_STAGE(bufoff, gbase, voff) do { _Pragma("unroll") for (int _i = 0; _i < 2; ++_i) \
        __builtin_amdgcn_global_load_lds((const unsigned*)((const char*)(gbase) + (voff)[_i]), (LAS unsigned*)(lds + (bufoff) + ldsw + _i * 8192), 16, 0, 0); } while (0)
#define PG_LDA(dst, b, h) do { _Pragma("unroll") for (int m = 0; m < 4; ++m) _Pragma("unroll") for (int k = 0; k < 2; ++k) dst[m][k] = *(const LAS bf16x8*)(lds + PG_SA(b, h) + aoff + m * 2048 + k * 1024); } while (0)
#define PG_LDB(dst, b, h) do { _Pragma("unroll") for (int n = 0; n < 2; ++n) _Pragma("unroll") for (int k = 0; k < 2; ++k) dst[n][k] = *(const LAS bf16x8*)(lds + PG_SB(b, h) + boff + n * 2048 + k * 1024); } while (0)
#define PG_MMA(ai, bj, At, Bt) do { __builtin_amdgcn_s_setprio(1); _Pragma("unroll") for (int m = 0; m < 4; ++m) _Pragma("unroll") for (int n = 0; n < 2; ++n) _Pragma("unroll") for (int k = 0; k < 2; ++k) \
        acc[ai][bj][m][n] = __builtin_amdgcn_mfma_f32_16x16x32_bf16(Bt[n][k], At[m][k], acc[ai][bj][m][n], 0, 0, 0); __builtin_amdgcn_s_setprio(0); } while (0)
#define PG_WAIT_V(n) asm volatile("s_waitcnt vmcnt(" #n ")" ::: "memory")
#define PG_WAIT_L(n) asm volatile("s_waitcnt lgkmcnt(" #n ")" ::: "memory")
#define PG_BAR __builtin_amdgcn_s_barrier()
#define PG_SCHED __builtin_amdgcn_sched_barrier(0)
    Unit cur, nxt; int ui = 0;
    if (!S.next(0, cur)) return;
    f32x4 acc[2][2][4][2];
#pragma unroll
    for (int a = 0; a < 2; ++a)
#pragma unroll
        for (int b = 0; b < 2; ++b)
#pragma unroll
            for (int m = 0; m < 4; ++m)
#pragma unroll
                for (int n = 0; n < 2; ++n) acc[a][b][m][n] = (f32x4){0.f, 0.f, 0.f, 0.f};
    bf16x8 At[4][2], B0[2][2], B1[2][2];
    unsigned va[2][2];
    setA(va, cur);
    const char* cA = (const char*)g.A + cur.aoff; const char* cB = (const char*)g.Bt + cur.boff;
    PG_STAGE(PG_SB(0, 0), cB, voffB); PG_STAGE(PG_SB(0, 1), cB + hstepB, voffB); PG_STAGE(PG_SA(0, 0), cA, va[0]); PG_STAGE(PG_SA(0, 1), cA, va[1]);
    if (wr == 1) PG_BAR;
    PG_WAIT_V(2); PG_BAR;
    PG_STAGE(PG_SB(1, 0), cB + kstep, voffB); PG_STAGE(PG_SA(1, 0), cA + kstep, va[0]); PG_STAGE(PG_SB(1, 1), cB + hstepB + kstep, voffB);
    PG_WAIT_V(6); PG_BAR;
    for (;;) {
        const bool has_next = S.next(ui + 1, nxt);
        const char* nA = has_next ? (const char*)g.A + nxt.aoff : cA; const char* nB = has_next ? (const char*)g.Bt + nxt.boff : cB;
        for (int t = 0; t < nt; t += 2) {
            const bool last = (t == nt - 2);
            const char* a1 = cA + (size_t)(t + 1) * kstep;
            const char* a2 = last ? nA : cA + (size_t)(t + 2) * kstep; const char* b2 = last ? nB : cB + (size_t)(t + 2) * kstep;
            const char* a3 = a2 + kstep; const char* b3 = b2 + kstep;
            PG_LDB(B0, 0, 0); PG_LDB(B1, 0, 1); PG_SCHED; PG_LDA(At, 0, 0); PG_STAGE(PG_SA(1, 1), a1, va[1]);
            PG_WAIT_V(8); PG_WAIT_L(0); PG_BAR; PG_MMA(0, 0, At, B0); PG_MMA(0, 1, At, B1); PG_BAR; PG_SCHED;
            if constexpr (GATHER) { if (last && has_next) setA(va, nxt); }
            PG_LDA(At, 0, 1); PG_STAGE(PG_SB(0, 0), b2, voffB); PG_STAGE(PG_SB(0, 1), b2 + hstepB, voffB); PG_STAGE(PG_SA(0, 0), a2, va[0]);
            PG_WAIT_V(8); PG_WAIT_L(0); PG_BAR; PG_MMA(1, 0, At, B0); PG_MMA(1, 1, At, B1); PG_BAR; PG_SCHED;
            PG_LDB(B0, 1, 0); PG_LDB(B1, 1, 1); PG_SCHED; PG_LDA(At, 1, 0); PG_STAGE(PG_SA(0, 1), a2, va[1]);
            PG_WAIT_V(8); PG_WAIT_L(0); PG_BAR; PG_MMA(0, 0, At, B0); PG_MMA(0, 1, At, B1); PG_BAR; PG_SCHED;
            PG_LDA(At, 1, 1); PG_STAGE(PG_SB(1, 0), b3, voffB); PG_STAGE(PG_SB(1, 1), b3 + hstepB, voffB); PG_STAGE(PG_SA(1, 0), a3, va[0]);
            PG_WAIT_V(8); PG_WAIT_L(0); PG_BAR; PG_MMA(1, 0, At, B0); PG_MMA(1, 1, At, B1); PG_BAR; PG_SCHED;
        }
        if (wr == 0) PG_BAR;
        E(acc, cur, wr, wc, fr, fq);
        if (!has_next) break;
#pragma unroll
        for (int a = 0; a < 2; ++a)
#pragma unroll
            for (int b = 0; b < 2; ++b)
#pragma unroll
                for (int m = 0; m < 4; ++m)
#pragma unroll
                    for (int n = 0; n < 2; ++n) acc[a][b][m][n] = (f32x4){0.f, 0.f, 0.f, 0.f};
        cur = nxt; cA = nA; cB = nB; ++ui;
        if (wr == 1) PG_BAR;
    }
    PG_WAIT_V(0);
    PG_BAR;
#undef PG_SA
#undef PG_SB
#undef PG_STAGE
#undef PG_LDA
#undef PG_LDB
#undef PG_MMA
#undef PG_WAIT_V
#undef PG_WAIT_L
#undef PG_BAR
#undef PG_SCHED
}

#define XB_TMO      128
#define XB_XCNT(j)  (256  + 64 * (j))
#define XB_XSUB(j)  (1280 + 64 * (j))
#define XB_XGEN(j)  (2304 + 64 * (j))
#define XB_TOP      3328
#define XB_TOPGEN   3392
#define XCD_BAR_WORDS 3456
#define XB_SPIN_CAP (1u << 22)
__device__ __forceinline__ unsigned xb_ld(unsigned* p)              { return __hip_atomic_load(p, __ATOMIC_RELAXED, __HIP_MEMORY_SCOPE_AGENT); }
__device__ __forceinline__ unsigned xb_add(unsigned* p, unsigned v) { return __hip_atomic_fetch_add(p, v, __ATOMIC_RELAXED, __HIP_MEMORY_SCOPE_AGENT); }
__device__ __forceinline__ unsigned xb_xcc_id() { return (unsigned)__builtin_amdgcn_s_getreg((3 << 11) | 20) & 0xFu; }
#define XB_SPIN(cond, bar) do { unsigned _sp = 0; while (cond) { __builtin_amdgcn_s_sleep(1); \
    if ((++_sp & 255u) == 0u) { if (xb_ld(&(bar)[XB_TMO])) break; if (_sp > XB_SPIN_CAP) { atomicAdd(&(bar)[XB_TMO], 1u); break; } } } } while (0)
struct XcdBarrier { unsigned* bar; unsigned x; volatile LAS unsigned* st; };
__device__ __forceinline__ XcdBarrier xcd_barrier_post(unsigned* bar, volatile LAS unsigned* st) {
    XcdBarrier b; b.bar = bar; b.x = xb_xcc_id(); b.st = st;
    if (threadIdx.x == 0) (void)xb_add(&bar[XB_XCNT(b.x)], 1u);
    return b;
}
__device__ __forceinline__ void xcd_barrier_complete(unsigned* bar, unsigned x, unsigned& nloc, unsigned& nx) {
    const unsigned G = gridDim.x * gridDim.y * gridDim.z;
    unsigned sum, cnt, mine, sp = 0u;
    for (;;) {
        sum = 0u; cnt = 0u; mine = 0u;
#pragma unroll
        for (unsigned j = 0; j < 16; ++j) { const unsigned c = xb_ld(&bar[XB_XCNT(j)]); sum += c; cnt += (c > 0u) ? 1u : 0u; mine = (j == x) ? c : mine; }
        if (sum == G) break;
        __builtin_amdgcn_s_sleep(1);
        if ((++sp & 255u) == 0u) { if (xb_ld(&bar[XB_TMO])) break; if (sp > XB_SPIN_CAP) { atomicAdd(&bar[XB_TMO], 1u); break; } }
    }
    nloc = mine > 0u ? mine : 1u; nx = cnt > 0u ? cnt : 1u;
}
__device__ __forceinline__ void xcd_barrier(const XcdBarrier& b) {
    asm volatile("s_waitcnt vmcnt(0)" ::: "memory");
    __syncthreads();
    if (threadIdx.x == 0) {
        unsigned* bar = b.bar;
        __builtin_amdgcn_s_waitcnt(0);
        unsigned nloc = b.st[0], nx = b.st[1];
        if (nloc == 0u) { xcd_barrier_complete(bar, b.x, nloc, nx); b.st[0] = nloc; b.st[1] = nx; }
        const unsigned old = xb_add(&bar[XB_XSUB(b.x)], 1u);
        const unsigned gen = old / nloc;
        if (old + 1u == (gen + 1u) * nloc) {
            __builtin_amdgcn_fence(__ATOMIC_RELEASE, "agent");
            asm volatile("s_waitcnt vmcnt(0)" ::: "memory");
            const unsigned og = xb_add(&bar[XB_TOP], 1u);
            const unsigned tg = og / nx;
            if (og + 1u == (tg + 1u) * nx) xb_add(&bar[XB_TOPGEN], 1u);
            else XB_SPIN(xb_ld(&bar[XB_TOPGEN]) == tg, bar);
            __builtin_amdgcn_fence(__ATOMIC_ACQUIRE, "agent");
            xb_add(&bar[XB_XGEN(b.x)], 1u);
            asm volatile("s_waitcnt vmcnt(0)" ::: "memory");
        } else {
            XB_SPIN(xb_ld(&bar[XB_XGEN(b.x)]) == gen, bar);
            __builtin_amdgcn_fence(__ATOMIC_ACQUIRE, "agent");
            asm volatile("s_waitcnt vmcnt(0)" ::: "memory");
        }
    }
    __syncthreads();
}

__device__ __forceinline__ void row_load_f32(const float* rowp, int lane, float (&v)[16]) {
#pragma unroll
    for (int k = 0; k < 2; ++k) { const f32x4 a = *(const f32x4*)(rowp + 512 * k + 8 * lane), b = *(const f32x4*)(rowp + 512 * k + 8 * lane + 4);
#pragma unroll
        for (int j = 0; j < 4; ++j) { v[8 * k + j] = a[j]; v[8 * k + 4 + j] = b[j]; } }
}
__device__ __forceinline__ void row_store_f32(float* rowp, int lane, const float (&v)[16]) {
#pragma unroll
    for (int k = 0; k < 2; ++k) { *(f32x4*)(rowp + 512 * k + 8 * lane) = (f32x4){v[8 * k], v[8 * k + 1], v[8 * k + 2], v[8 * k + 3]}; *(f32x4*)(rowp + 512 * k + 8 * lane + 4) = (f32x4){v[8 * k + 4], v[8 * k + 5], v[8 * k + 6], v[8 * k + 7]}; }
}
__device__ __forceinline__ void row_store_bf16(bf16_t* rowp, int lane, const float (&v)[16]) {
#pragma unroll
    for (int k = 0; k < 2; ++k) { u32x4 w; w.x = pk_bf16(v[8 * k], v[8 * k + 1]); w.y = pk_bf16(v[8 * k + 2], v[8 * k + 3]); w.z = pk_bf16(v[8 * k + 4], v[8 * k + 5]); w.w = pk_bf16(v[8 * k + 6], v[8 * k + 7]);
        *(u32x4*)(rowp + 512 * k + 8 * lane) = w; }
}
__device__ __forceinline__ void row_load_bf16(const bf16_t* rowp, int lane, float (&v)[16]) {
#pragma unroll
    for (int k = 0; k < 2; ++k) { const u32x4 w = *(const u32x4*)(rowp + 512 * k + 8 * lane);
        v[8 * k] = bf_lo(w.x); v[8 * k + 1] = bf_hi(w.x); v[8 * k + 2] = bf_lo(w.y); v[8 * k + 3] = bf_hi(w.y); v[8 * k + 4] = bf_lo(w.z); v[8 * k + 5] = bf_hi(w.z); v[8 * k + 6] = bf_lo(w.w); v[8 * k + 7] = bf_hi(w.w); }
}
__device__ __forceinline__ void row_rmsnorm(const float (&x)[16], const float* g, int lane, float (&o)[16]) {
    float ss = 0.f;
#pragma unroll
    for (int j = 0; j < 16; ++j) ss += x[j] * x[j];
    ss = wave_sum(ss);
    const float rstd = rsqrtf(ss * (1.0f / 1024.0f) + EPS);
    float gv[16]; row_load_f32(g, lane, gv);
#pragma unroll
    for (int j = 0; j < 16; ++j) o[j] = x[j] * rstd * gv[j];
}

struct CvtJob { const float* src; bf16_t* dst; const float* kscale; int N, K; };
constexpr int NT_AIN = 2048, NT_AOUT = 1024, NT_BIN = 512, NT_BOUT = 512, NT_G = 16384, NT_U = 16384, NT_D = 16384;
constexpr int NT_TOTAL = NT_AIN + NT_AOUT + NT_BIN + NT_BOUT + NT_G + NT_U + NT_D;
__device__ __forceinline__ void cvt_decode(KP p, int r, CvtJob& jb) {
    unsigned char* ws = p->ws; const float* src; int N, K; bf16_t* dst; int tk, tn, drow; jb.kscale = nullptr;
    if (r < NT_AIN) { const int m = r >> 10, q = r & 1023; K = 1024; N = 4096; tk = q >> 6; tn = q & 63; src = p->in[3] + (size_t)m * K * N; dst = (bf16_t*)(ws + OFF_WAIN) + (size_t)m * N * K; drow = tn * 64; jb.kscale = p->in[1] + (2 * m) * 1024 + tk * 64; }
    else if ((r -= NT_AIN) < NT_AOUT) { const int m = r >> 9, q = r & 511; K = 2048; N = 1024; tk = q >> 4; tn = q & 15; src = p->in[8] + (size_t)m * K * N; dst = (bf16_t*)(ws + OFF_WAOUT) + (size_t)m * N * K; drow = tn * 64; }
    else if ((r -= NT_AOUT) < NT_BIN) { const int m = r >> 8, q = r & 255; K = 1024; N = 1024; tk = q >> 4; tn = q & 15; src = p->in[9] + (size_t)m * K * N; dst = (bf16_t*)(ws + OFF_WBIN) + (size_t)m * N * K; drow = tn * 64; jb.kscale = p->in[1] + (2 * m + 1) * 1024 + tk * 64; }
    else if ((r -= NT_BIN) < NT_BOUT) { const int m = r >> 8, q = r & 255; K = 1024; N = 1024; tk = q >> 4; tn = q & 15; src = p->in[12] + (size_t)m * K * N; dst = (bf16_t*)(ws + OFF_WBT) + (size_t)m * N * K; drow = tn * 64; }
    else if ((r -= NT_BOUT) < NT_G + NT_U) { const int up = r >= NT_G; if (up) r -= NT_G; const int m = r >> 7, q = r & 127; K = 1024; N = 512; tk = q >> 3; tn = q & 7;
        src = p->in[up ? 18 : 17] + (size_t)m * K * N; dst = (bf16_t*)(ws + OFF_WGU) + (size_t)m * 1024 * 1024; const int n0 = tn * 64; drow = (n0 >> 7) * 256 + (n0 & 127) + (up ? 128 : 0); jb.kscale = p->in[2] + (m >> 5) * 1024 + tk * 64; }
    else { r -= NT_G + NT_U; const int m = r >> 7, q = r & 127; K = 512; N = 1024; tk = q >> 4; tn = q & 15; src = p->in[19] + (size_t)m * K * N; dst = (bf16_t*)(ws + OFF_WDN) + (size_t)m * N * K; drow = tn * 64; }
    jb.src = src + (size_t)(tk * 64) * N + tn * 64; jb.dst = dst + (size_t)drow * K + tk * 64; jb.N = N; jb.K = K;
}
__device__ void phase_prep(LAS unsigned char* lds, KP p, int c, int G) {
    const int tid = tid_opaque();
    const int n4 = tid & 15, kp = tid >> 4, rn = tid >> 3, cc = tid & 7;
    constexpr int NB = 4;
    CvtJob cur[NB], nxt[NB]; f32x4 a[NB], b[NB], na[NB], nb[NB];
    float k0 = 1.f, k1 = 1.f, nk0 = 1.f, nk1 = 1.f;
#pragma unroll
    for (int q = 0; q < NB; ++q) { const int t = c * NB + q; if (t < NT_TOTAL) { cvt_decode(p, t, cur[q]); a[q] = __builtin_nontemporal_load((const f32x4*)(cur[q].src + (size_t)(2 * kp) * cur[q].N + 4 * n4)); b[q] = __builtin_nontemporal_load((const f32x4*)(cur[q].src + (size_t)(2 * kp + 1) * cur[q].N + 4 * n4)); } }
    if (c * NB < NT_TOTAL && cur[0].kscale) { k0 = cur[0].kscale[2 * kp]; k1 = cur[0].kscale[2 * kp + 1]; }
    int buf = 0;
    for (int t0 = c * NB; t0 < NT_TOTAL; t0 += NB * G) {
#pragma unroll
        for (int q = 0; q < NB; ++q) if (t0 + q < NT_TOTAL) {
            LAS unsigned* L = (LAS unsigned*)(lds + (buf * NB + q) * 8704);
            const f32x4 av = a[q] * k0, bv = b[q] * k1;
#pragma unroll
            for (int jj = 0; jj < 4; ++jj) L[(4 * n4 + jj) * 33 + kp] = pk_bf16(av[jj], bv[jj]); }
        nk0 = 1.f; nk1 = 1.f;
#pragma unroll
        for (int q = 0; q < NB; ++q) { const int t = t0 + NB * G + q; if (t < NT_TOTAL) { cvt_decode(p, t, nxt[q]); na[q] = __builtin_nontemporal_load((const f32x4*)(nxt[q].src + (size_t)(2 * kp) * nxt[q].N + 4 * n4)); nb[q] = __builtin_nontemporal_load((const f32x4*)(nxt[q].src + (size_t)(2 * kp + 1) * nxt[q].N + 4 * n4)); } }
        if (t0 + NB * G < NT_TOTAL && nxt[0].kscale) { nk0 = nxt[0].kscale[2 * kp]; nk1 = nxt[0].kscale[2 * kp + 1]; }
        __syncthreads();
#pragma unroll
        for (int q = 0; q < NB; ++q) if (t0 + q < NT_TOTAL) {
            LAS unsigned* L = (LAS unsigned*)(lds + (buf * NB + q) * 8704);
            u32x4 w; w.x = L[rn * 33 + 4 * cc]; w.y = L[rn * 33 + 4 * cc + 1]; w.z = L[rn * 33 + 4 * cc + 2]; w.w = L[rn * 33 + 4 * cc + 3];
            __builtin_nontemporal_store(w, (u32x4*)(cur[q].dst + (size_t)rn * cur[q].K + 8 * cc)); }
#pragma unroll
        for (int q = 0; q < NB; ++q) { cur[q] = nxt[q]; a[q] = na[q]; b[q] = nb[q]; }
        k0 = nk0; k1 = nk1;
        buf ^= 1;
    }
    { bf16_t* wbg = (bf16_t*)(p->ws + OFF_WBG);
      for (int i = c * NTHREADS + tid; i < 2 * 4 * 256 * 256 / 4; i += G * NTHREADS) {
          const int m4 = (i & 63) * 4, jg = i >> 14;
          const f32x4 w = *(const f32x4*)(p->in[10] + (size_t)i * 4), s = *(const f32x4*)(p->in[11] + jg * 256 + m4);
          u32x2 o; o.x = pk_bf16(w[0] * s[0], w[1] * s[1]); o.y = pk_bf16(w[2] * s[2], w[3] * s[3]);
          *(u32x2*)(wbg + (size_t)i * 4) = o; } }
    const int wid = __builtin_amdgcn_readfirstlane(tid >> 6), lane = tid & 63;
    bf16_t* XB0 = (bf16_t*)(p->ws + OFF_XB); float* rstd_arr = (float*)(p->ws + OFF_RSTD); const float* xin = p->in[0];
    const int nwaves = G * 8, rpw = (T_ + nwaves - 1) / nwaves;
    const int w0 = (c * 8 + wid) * rpw; int nr = T_ - w0; nr = nr > rpw ? rpw : nr;
    if (nr > 0) {
        float x[16], xn[16]; row_load_f32(xin + (size_t)w0 * 1024, lane, x);
        for (int r = 0; r < nr; ++r) {
            const int row = w0 + r;
            if (r + 1 < nr) row_load_f32(xin + (size_t)(row + 1) * 1024, lane, xn);
            row_store_bf16(XB0 + (size_t)row * 1024, lane, x);
            float ss = 0.f;
#pragma unroll
            for (int jj = 0; jj < 16; ++jj) ss += x[jj] * x[jj];
            ss = wave_sum(ss);
            const float rstd = rsqrtf(ss * (1.0f / 1024.0f) + EPS);
            if (lane == 0) rstd_arr[row] = rstd;
#pragma unroll
            for (int jj = 0; jj < 16; ++jj) x[jj] = xn[jj];
        }
    }
}

constexpr int SP_WL = 0, SP_WPITCH = 272, SP_VL = 128 * SP_WPITCH, SP_VPITCH = 528, SP_RS = SP_VL + 128 * SP_VPITCH;
__device__ void phase_spatial(LAS unsigned char* lds, KP p, int j, int c, int G) {
    const int tid = tid_opaque(), wid = tid >> 6, lane = tid & 63, fr = lane & 15, fq = lane >> 4;
    const bf16_t* Z = (const bf16_t*)(p->ws + OFF_Z); bf16_t* YS = (bf16_t*)(p->ws + OFF_YS);
    const float* Ws = p->in[6] + (size_t)j * 8 * 128 * 128; const float* bs = p->in[7] + j * 8 * 128; const float* gv = p->in[5] + j * 2048; const float* vss = (const float*)(p->ws + OFF_VSS) + (size_t)j * T_ * 32;
    LAS float* RS = (LAS float*)(lds + SP_RS);
    const int dw = wid * 32;
    int wh = -1; u32x4 vreg[8]; f32x4 wreg[8]; f32x4 sreg[2];
    float bsr[8]; f32x4 g0, g1;
#pragma unroll
    for (int jt = 0; jt < 8; ++jt) bsr[jt] = 0.f;
    g0 = (f32x4){0.f, 0.f, 0.f, 0.f}; g1 = g0;
    u32x4 ureg[8];
    auto issue = [&](int unit) {
        const int h = unit & 7, bcn = unit >> 3, row0 = bcn * 128;
        { const f32x4* vp = (const f32x4*)(vss + (size_t)(row0 + (tid >> 2)) * 32 + (tid & 3) * 8); sreg[0] = vp[0]; sreg[1] = vp[1]; }
#pragma unroll
        for (int it = 0; it < 8; ++it) { const int r = it * 16 + (tid >> 5), ch = tid & 31; vreg[it] = __builtin_nontemporal_load((const u32x4*)(Z + ((size_t)(bcn * 16 + 8 + h) * 128 + r) * 256 + ch * 8)); }
        if (h != wh) { wh = h; const int t = tid >> 2, s0 = (tid & 3) * 32; const float* wp = Ws + ((size_t)h * 128 + t) * 128 + s0;
#pragma unroll
          for (int q = 0; q < 8; ++q) wreg[q] = *(const f32x4*)(wp + 4 * q);
#pragma unroll
          for (int jt = 0; jt < 8; ++jt) bsr[jt] = bs[h * 128 + 16 * jt + fr];
          g0 = *(const f32x4*)(gv + h * 256 + dw + 8 * fq); g1 = *(const f32x4*)(gv + h * 256 + dw + 8 * fq + 4); }
    };
    auto issue_u = [&](int unit, int hf) {
        const int h = unit & 7, bcn = unit >> 3;
#pragma unroll
        for (int jj = 0; jj < 4; ++jj) { const int jt = 4 * hf + jj; ureg[jt] = __builtin_nontemporal_load((const u32x4*)(Z + ((size_t)(bcn * 16 + h) * 128 + 16 * jt + fr) * 256 + dw + 8 * fq)); }
    };
    if (c < 2048) { issue(c); issue_u(c, 0); issue_u(c, 1); }
    for (int unit = c; unit < 2048; unit += G) {
        const int h = unit & 7, bc = unit >> 3, row0 = bc * 128;
        const int colb = h * 256 + dw + 8 * fq;
        { float s = ((sreg[0][0] + sreg[0][1]) + (sreg[0][2] + sreg[0][3])) + ((sreg[1][0] + sreg[1][1]) + (sreg[1][2] + sreg[1][3]));
          s += __shfl_xor(s, 1); s += __shfl_xor(s, 2);
          if ((tid & 3) == 0) RS[tid >> 2] = rsqrtf(s * (1.0f / 2048.0f) + EPS); }
#pragma unroll
        for (int it = 0; it < 8; ++it) { const int r = it * 16 + (tid >> 5), ch = tid & 31; *(LAS u32x4*)(lds + SP_VL + r * SP_VPITCH + ch * 16) = vreg[it]; }
        __syncthreads();
        { const int t = tid >> 2, s0 = (tid & 3) * 32;
#pragma unroll
          for (int q = 0; q < 4; ++q) { const f32x4 a = wreg[2 * q], b = wreg[2 * q + 1]; const int s = s0 + 8 * q;
              u32x4 w; w.x = pk_bf16(a[0] * RS[s], a[1] * RS[s + 1]); w.y = pk_bf16(a[2] * RS[s + 2], a[3] * RS[s + 3]); w.z = pk_bf16(b[0] * RS[s + 4], b[1] * RS[s + 5]); w.w = pk_bf16(b[2] * RS[s + 6], b[3] * RS[s + 7]);
              *(LAS u32x4*)(lds + SP_WL + t * SP_WPITCH + s * 2) = w; } }
        __syncthreads();
        if (unit + G < 2048) issue(unit + G);
        const int li = lane & 15, q = li >> 2, pp = li & 3;
        const LAS unsigned char* vbase = lds + SP_VL + (8 * fq + q) * SP_VPITCH + (dw + 8 * pp) * 2;
        const LAS unsigned char* wbase = lds + SP_WL + fr * SP_WPITCH + (8 * fq) * 2;
#pragma unroll
        for (int hf = 0; hf < 2; ++hf) {
            f32x4 acc[2][4];
#pragma unroll
            for (int n = 0; n < 2; ++n)
#pragma unroll
                for (int jj = 0; jj < 4; ++jj) acc[n][jj] = (f32x4){0.f, 0.f, 0.f, 0.f};
#pragma unroll
            for (int ks = 0; ks < 4; ++ks) {
                bf16x8 af[2];
#pragma unroll
                for (int n = 0; n < 2; ++n) {
                    const s16x4 lo = __builtin_bit_cast(s16x4, __builtin_amdgcn_ds_read_tr16_b64_v4i16((LAS s16x4*)(vbase + (32 * ks) * SP_VPITCH + 8 * n)));
                    const s16x4 hi = __builtin_bit_cast(s16x4, __builtin_amdgcn_ds_read_tr16_b64_v4i16((LAS s16x4*)(vbase + (32 * ks + 4) * SP_VPITCH + 8 * n)));
                    af[n] = (bf16x8){lo[0], lo[1], lo[2], lo[3], hi[0], hi[1], hi[2], hi[3]}; }
#pragma unroll
                for (int jj = 0; jj < 4; ++jj) { const bf16x8 bfr = *(const LAS bf16x8*)(wbase + (16 * (4 * hf + jj)) * SP_WPITCH + (32 * ks) * 2);
                    acc[0][jj] = __builtin_amdgcn_mfma_f32_16x16x32_bf16(af[0], bfr, acc[0][jj], 0, 0, 0);
                    acc[1][jj] = __builtin_amdgcn_mfma_f32_16x16x32_bf16(af[1], bfr, acc[1][jj], 0, 0, 0); }
            }
#pragma unroll
            for (int jj = 0; jj < 4; ++jj) { const int jt = 4 * hf + jj, t = 16 * jt + fr, row = row0 + t; const float bsv = bsr[jt];
                const u32x4 uw = ureg[jt];
                const f32x2 ua = gelu_pk((f32x2){bf_lo(uw.x), bf_hi(uw.x)}), ub = gelu_pk((f32x2){bf_lo(uw.y), bf_hi(uw.y)}), uc = gelu_pk((f32x2){bf_lo(uw.z), bf_hi(uw.z)}), ud = gelu_pk((f32x2){bf_lo(uw.w), bf_hi(uw.w)});
                const f32x4 s0 = acc[0][jj] * g0 + bsv, s1 = acc[1][jj] * g1 + bsv;
                u32x4 w; w.x = pk_bf16(ua.x * s0[0], ua.y * s0[1]); w.y = pk_bf16(ub.x * s0[2], ub.y * s0[3]);
                w.z = pk_bf16(uc.x * s1[0], uc.y * s1[1]); w.w = pk_bf16(ud.x * s1[2], ud.y * s1[3]);
                *(u32x4*)(YS + (size_t)row * 2048 + colb) = w; }
            if (unit + G < 2048) issue_u(unit + G, hf);
        }
        __syncthreads();
    }
}

template <int GRP>
__device__ __forceinline__ void pool_item(const bf16_t* V1, bf16_t* Dp, int row0, int ch) {
    constexpr int W = 2 << GRP, HW = W / 2, NR = 8 + W - 1;
    const int t0 = row0 & (SEQ - 1);
    const bf16_t* base = V1 + (size_t)(row0 - t0) * 1024 + ch * 8;
    u32x4 buf[NR];
#pragma unroll
    for (int jj = 0; jj < NR; ++jj) { const int t = t0 - HW + jj; buf[jj] = (t >= 0 && t < SEQ) ? *(const u32x4*)(base + (size_t)t * 1024) : (u32x4){0u, 0u, 0u, 0u}; }
    float s[8];
#pragma unroll
    for (int e = 0; e < 8; ++e) s[e] = 0.f;
#pragma unroll
    for (int jj = 0; jj < W - 1; ++jj) { const u32x4 v = buf[jj];
        s[0] += bf_lo(v.x); s[1] += bf_hi(v.x); s[2] += bf_lo(v.y); s[3] += bf_hi(v.y); s[4] += bf_lo(v.z); s[5] += bf_hi(v.z); s[6] += bf_lo(v.w); s[7] += bf_hi(v.w); }
#pragma unroll
    for (int i = 0; i < 8; ++i) {
        { const u32x4 v = buf[i + W - 1];
          s[0] += bf_lo(v.x); s[1] += bf_hi(v.x); s[2] += bf_lo(v.y); s[3] += bf_hi(v.y); s[4] += bf_lo(v.z); s[5] += bf_hi(v.z); s[6] += bf_lo(v.w); s[7] += bf_hi(v.w); }
        const int t = t0 + i; int lo = t - HW, hi = t + HW; lo = lo < 0 ? 0 : lo; hi = hi > SEQ ? SEQ : hi;
        const float inv = 1.0f / (float)(hi - lo);
        const u32x4 v = buf[i + HW];
        u32x4 o; o.x = pk_bf16(s[0] * inv - bf_lo(v.x), s[1] * inv - bf_hi(v.x)); o.y = pk_bf16(s[2] * inv - bf_lo(v.y), s[3] * inv - bf_hi(v.y));
        o.z = pk_bf16(s[4] * inv - bf_lo(v.z), s[5] * inv - bf_hi(v.z)); o.w = pk_bf16(s[6] * inv - bf_lo(v.w), s[7] * inv - bf_hi(v.w));
        *(u32x4*)(Dp + (size_t)(row0 + i) * 1024 + ch * 8) = o;
        { const u32x4 q = buf[i];
          s[0] -= bf_lo(q.x); s[1] -= bf_hi(q.x); s[2] -= bf_lo(q.y); s[3] -= bf_hi(q.y); s[4] -= bf_lo(q.z); s[5] -= bf_hi(q.z); s[6] -= bf_lo(q.w); s[7] -= bf_hi(q.w); }
    }
}
__device__ void phase_pool(KP p, int c, int G) {
    const bf16_t* V1 = (const bf16_t*)(p->ws + OFF_Z); bf16_t* Dp = (bf16_t*)(p->ws + OFF_Z) + (size_t)T_ * 1024;
    const int tid = tid_opaque(), wid = __builtin_amdgcn_readfirstlane(tid >> 6), lane = tid & 63;
    for (int wi = c * 8 + wid; wi < (T_ / 16) * 4; wi += G * 8) {
        const int g = wi & 3, rp = wi >> 2;
        const int row0 = rp * 16 + (lane >> 5) * 8, ch = g * 32 + (lane & 31);
        switch (g) {
        case 0: pool_item<0>(V1, Dp, row0, ch); break;
        case 1: pool_item<1>(V1, Dp, row0, ch); break;
        case 2: pool_item<2>(V1, Dp, row0, ch); break;
        default: pool_item<3>(V1, Dp, row0, ch); break;
        }
    }
}

constexpr int RW_PITCH = 1032;
constexpr int RW_BYTES = 36 * RW_PITCH * 2;
__device__ void phase_router(LAS unsigned char* lds, KP p, int layer, int c, int G, int cset) {
    const int tid = tid_opaque(), wid = __builtin_amdgcn_readfirstlane(tid >> 6), lane = tid & 63, fr = lane & 15, fq = lane >> 4;
    LAS bf16_t* WH = (LAS bf16_t*)lds; LAS bf16_t* WL = (LAS bf16_t*)(lds + RW_BYTES);
    const float* rgw = p->in[13] + (size_t)layer * 1024 * 4; const float* rgb = p->in[14] + layer * 4;
    const float* rew = p->in[15] + (size_t)layer * 1024 * 32; const float* reb = p->in[16] + layer * 32;
    const float* xss = (const float*)(p->ws + OFF_XSS);
    u32x4 xa[16], xb[16]; f32x4 ppx = (f32x4){0.f, 0.f, 0.f, 0.f};
    const bool act0 = c * 8 + wid < T_ / 16;
    const bf16_t* xr0 = (const bf16_t*)(p->ws + OFF_XB) + (size_t)((act0 ? c * 8 + wid : 0) * 16 + fr) * 1024 + 8 * fq;
    if (act0) { ppx = *(const f32x4*)(xss + (size_t)((c * 8 + wid) * 16 + fr) * 16 + 4 * fq);
#pragma unroll
        for (int ks = 0; ks < 16; ++ks) xa[ks] = *(const u32x4*)(xr0 + 32 * ks); }
    else {
#pragma unroll
        for (int ks = 0; ks < 16; ++ks) xa[ks] = (u32x4){0u, 0u, 0u, 0u}; }
    const float* gf = p->in[2] + layer * 1024;
#pragma unroll 1
    for (int k = tid; k < 1024; k += NTHREADS) {
        const float gk = gf[k];
        const f32x4 a = *(const f32x4*)(rgw + k * 4) * gk;
#pragma unroll
        for (int jj = 0; jj < 4; ++jj) { const unsigned hi = pk_bf16(a[jj], 0.f) & 0xffffu; const float rem = a[jj] - __uint_as_float(hi << 16);
            WH[jj * RW_PITCH + k] = (bf16_t)hi; WL[jj * RW_PITCH + k] = (bf16_t)(pk_bf16(rem, 0.f) & 0xffffu); }
#pragma unroll
        for (int q = 0; q < 8; ++q) { const f32x4 b = *(const f32x4*)(rew + k * 32 + 4 * q) * gk;
#pragma unroll
            for (int jj = 0; jj < 4; ++jj) { const unsigned hi = pk_bf16(b[jj], 0.f) & 0xffffu; const float rem = b[jj] - __uint_as_float(hi << 16);
                WH[(4 + 4 * q + jj) * RW_PITCH + k] = (bf16_t)hi; WL[(4 + 4 * q + jj) * RW_PITCH + k] = (bf16_t)(pk_bf16(rem, 0.f) & 0xffffu); } }
    }
    LAS float* lbias = (LAS float*)(lds + LDS_MISC + 512);
    if (tid < 36) lbias[tid] = tid < 4 ? rgb[tid] : reb[tid - 4];
    __builtin_amdgcn_sched_barrier(0);
    if (act0) {
#pragma unroll
        for (int ks = 0; ks < 16; ++ks) xb[ks] = *(const u32x4*)(xr0 + 32 * (16 + ks)); }
    else {
#pragma unroll
        for (int ks = 0; ks < 16; ++ks) xb[ks] = (u32x4){0u, 0u, 0u, 0u}; }
    __syncthreads();
    float* rss = (float*)(p->ws + OFF_RSS);
    unsigned* cnt = (unsigned*)(p->ws + OFF_CTL) + CW_CNT + cset * 32 * 16;
    int* list = (int*)(p->ws + OFF_LIST); i32x4* slot = (i32x4*)(p->ws + OFF_SLOT); f32x2* gates = (f32x2*)(p->ws + OFF_GATE);
    LAS unsigned* lcnt = (LAS unsigned*)(lds + LDS_MISC + 64); LAS unsigned* lbase = lcnt + 32;
    int wrow[3];
#pragma unroll
    for (int t = 0; t < 3; ++t) { const int o = 16 * t + fr; wrow[t] = (o < 36 ? o : 35) * RW_PITCH + 8 * fq; }
    for (int cb = c * 8; cb < T_ / 16; cb += G * 8) {
        const int ch = cb + wid; const bool active = ch < T_ / 16;
        if (tid < 32) lcnt[tid] = 0u;
        __syncthreads();
        const int row = (active ? ch : 0) * 16 + fr;
        int e0 = 0, e1 = 0, k0 = 0, k1 = 0; float gt0 = 0.f, gt1 = 0.f, rstd_row = 0.f;
        if (active) {
            if (cb != c * 8) { const bf16_t* xr = (const bf16_t*)(p->ws + OFF_XB) + (size_t)row * 1024 + 8 * fq;
                ppx = *(const f32x4*)(xss + (size_t)row * 16 + 4 * fq);
#pragma unroll
                for (int ks = 0; ks < 16; ++ks) { xa[ks] = *(const u32x4*)(xr + 32 * ks); xb[ks] = *(const u32x4*)(xr + 32 * (16 + ks)); } }
            float ss = (ppx[0] + ppx[1]) + (ppx[2] + ppx[3]);
            ss += __shfl_xor(ss, 16); ss += __shfl_xor(ss, 32);
            const float rstd = rsqrtf(ss * (1.0f / 1024.0f) + EPS); rstd_row = rstd;
            f32x4 acc[3];
            const LAS bf16_t* whp[3]; const LAS bf16_t* wlp[3];
#pragma unroll
            for (int t = 0; t < 3; ++t) { acc[t] = (f32x4){0.f, 0.f, 0.f, 0.f}; whp[t] = WH + wrow[t]; wlp[t] = WL + wrow[t]; asm volatile("" : "+v"(whp[t]), "+v"(wlp[t])); }
#pragma unroll
            for (int ks = 0; ks < 32; ++ks) {
                const bf16x8 fh = __builtin_bit_cast(bf16x8, ks < 16 ? xa[ks & 15] : xb[ks & 15]);
#pragma unroll
                for (int t = 0; t < 3; ++t) { const bf16x8 wh = *(const LAS bf16x8*)(whp[t] + 32 * ks), wl = *(const LAS bf16x8*)(wlp[t] + 32 * ks);
                    acc[t] = __builtin_amdgcn_mfma_f32_16x16x32_bf16(wh, fh, acc[t], 0, 0, 0);
                    acc[t] = __builtin_amdgcn_mfma_f32_16x16x32_bf16(wl, fh, acc[t], 0, 0, 0); }
            }
#pragma unroll
            for (int t = 0; t < 3; ++t) acc[t] = acc[t] * rstd;
            f32x4 lg[3];
#pragma unroll
            for (int t = 0; t < 3; ++t)
#pragma unroll
                for (int r = 0; r < 4; ++r) { const int o = 16 * t + 4 * fq + r; const float b = lbias[o < 36 ? o : 35]; lg[t][r] = acc[t][r] + b; }
            float gl[4];
#pragma unroll
            for (int jj = 0; jj < 4; ++jj) gl[jj] = __shfl(lg[0][jj], fr);
            int gi = 0; float gm = gl[0];
#pragma unroll
            for (int jj = 1; jj < 4; ++jj) if (gl[jj] > gm) { gm = gl[jj]; gi = jj; }
            float gs = 0.f;
#pragma unroll
            for (int jj = 0; jj < 4; ++jj) gs += __expf(gl[jj] - gm);
            const float gw = 1.0f / gs;
            const int q1 = 1 + 2 * gi, q2 = 2 + 2 * gi, t1 = q1 >> 2, t2 = q2 >> 2;
            float el[8];
#pragma unroll
            for (int r = 0; r < 4; ++r) { const float c1 = t1 == 0 ? lg[0][r] : lg[1][r]; const float c2 = t2 == 0 ? lg[0][r] : t2 == 1 ? lg[1][r] : lg[2][r];
                el[r] = __shfl(c1, fr + 16 * (q1 & 3)); el[4 + r] = __shfl(c2, fr + 16 * (q2 & 3)); }
            int i0 = 0; float m0 = el[0];
#pragma unroll
            for (int jj = 1; jj < 8; ++jj) if (el[jj] > m0) { m0 = el[jj]; i0 = jj; }
            int i1 = -1; float m1 = -INFINITY;
#pragma unroll
            for (int jj = 0; jj < 8; ++jj) if (jj != i0 && el[jj] > m1) { m1 = el[jj]; i1 = jj; }
            const float ex = __expf(m1 - m0), w0 = 1.0f / (1.0f + ex), w1 = ex * w0;
            e0 = gi * 8 + i0; e1 = gi * 8 + i1; gt0 = gw * w0; gt1 = gw * w1;
            if (fq == 0) { k0 = (int)__hip_atomic_fetch_add(lcnt + e0, 1u, __ATOMIC_RELAXED, __HIP_MEMORY_SCOPE_WORKGROUP); k1 = (int)__hip_atomic_fetch_add(lcnt + e1, 1u, __ATOMIC_RELAXED, __HIP_MEMORY_SCOPE_WORKGROUP); }
        }
        __syncthreads();
        if (tid < 32) { const unsigned n = lcnt[tid]; lbase[tid] = n ? atomicAdd(cnt + tid * 16, n) : 0u; }
        __syncthreads();
        if (active && fq == 0) {
            const int p0 = (int)lbase[e0] + k0, p1 = (int)lbase[e1] + k1;
            list[e0 * LIST_CAP + p0] = row; list[e1 * LIST_CAP + p1] = row; rss[e0 * LIST_CAP + p0] = rstd_row; rss[e1 * LIST_CAP + p1] = rstd_row;
            slot[row] = (i32x4){e0, p0, e1, p1}; gates[row] = (f32x2){gt0, gt1};
        }
    }
}

struct CombRow { u32x4 x[2]; u32x4 y0[2], y1[2]; };
__device__ __forceinline__ void comb_load(CombRow& r, const bf16_t* xrow, const bf16_t* y0, const bf16_t* y1, int lane) {
#pragma unroll
    for (int k = 0; k < 2; ++k) { r.x[k] = *(const u32x4*)(xrow + 512 * k + 8 * lane);
        r.y0[k] = __builtin_nontemporal_load((const u32x4*)(y0 + 512 * k + 8 * lane)); r.y1[k] = __builtin_nontemporal_load((const u32x4*)(y1 + 512 * k + 8 * lane)); }
}
__device__ void phase_combine(KP p, int layer, int c, int G, float* Xout) {
    const int tid = tid_opaque(), wid = __builtin_amdgcn_readfirstlane(tid >> 6), lane = tid & 63;
    const unsigned* cnt = (const unsigned*)(p->ws + OFF_CTL) + CW_CNT + layer * 32 * 16;
    int tb;
    { int cn = 0; if (lane < 32) cn = (int)__hip_atomic_load(cnt + lane * 16, __ATOMIC_RELAXED, __HIP_MEMORY_SCOPE_AGENT);
      const int tl = (cn + 255) >> 8; int v = tl;
#pragma unroll
      for (int d = 1; d < 32; d <<= 1) { const int t = __shfl_up(v, d); if (lane >= d) v += t; }
      tb = v - tl; }
    const bf16_t* YM = (const bf16_t*)(p->ws + OFF_Z + HID_BYTES);
    const i32x4* slot = (const i32x4*)(p->ws + OFF_SLOT); const f32x2* gates = (const f32x2*)(p->ws + OFF_GATE);
    bf16_t* X = (bf16_t*)(p->ws + OFF_XB); float* rstd_arr = (float*)(p->ws + OFF_RSTD);
    const bool last = layer == 3; const float* gn = last ? p->in[20] : p->in[1] + (layer + 1) * 1024;
    float gv[16]; row_load_f32(gn, lane, gv);
    const int nwaves = G * 8, rpw = (T_ + nwaves - 1) / nwaves;
    const int w0 = (c * 8 + wid) * rpw; int nr = T_ - w0; nr = nr > rpw ? rpw : nr;
    if (nr <= 0) return;
    int r0v = 0, r1v = 0; float g0v = 0.f, g1v = 0.f;
    { i32x4 sm = (i32x4){0, 0, 0, 0}; f32x2 gm = (f32x2){0.f, 0.f};
      if (lane < nr) { sm = slot[w0 + lane]; gm = gates[w0 + lane]; }
      r0v = __shfl(tb, sm[0]) * 256 + sm[1]; r1v = __shfl(tb, sm[2]) * 256 + sm[3]; g0v = gm.x; g1v = gm.y; }
    CombRow cur, nxt;
    comb_load(cur, X + (size_t)w0 * 1024, YM + (size_t)__builtin_amdgcn_readlane(r0v, 0) * 1024, YM + (size_t)__builtin_amdgcn_readlane(r1v, 0) * 1024, lane);
    for (int r = 0; r < nr; ++r) {
        const int row = w0 + r;
        if (r + 1 < nr) comb_load(nxt, X + (size_t)(row + 1) * 1024, YM + (size_t)__builtin_amdgcn_readlane(r0v, r + 1) * 1024, YM + (size_t)__builtin_amdgcn_readlane(r1v, r + 1) * 1024, lane);
        const float g0 = __builtin_bit_cast(float, __builtin_amdgcn_readlane(__builtin_bit_cast(int, g0v), r)), g1 = __builtin_bit_cast(float, __builtin_amdgcn_readlane(__builtin_bit_cast(int, g1v), r));
        float x[16];
#pragma unroll
        for (int k = 0; k < 2; ++k) { const u32x4 a = cur.y0[k], b = cur.y1[k], xv = cur.x[k];
            x[8 * k + 0] = bf_lo(xv.x) + g0 * bf_lo(a.x) + g1 * bf_lo(b.x); x[8 * k + 1] = bf_hi(xv.x) + g0 * bf_hi(a.x) + g1 * bf_hi(b.x);
            x[8 * k + 2] = bf_lo(xv.y) + g0 * bf_lo(a.y) + g1 * bf_lo(b.y); x[8 * k + 3] = bf_hi(xv.y) + g0 * bf_hi(a.y) + g1 * bf_hi(b.y);
            x[8 * k + 4] = bf_lo(xv.z) + g0 * bf_lo(a.z) + g1 * bf_lo(b.z); x[8 * k + 5] = bf_hi(xv.z) + g0 * bf_hi(a.z) + g1 * bf_hi(b.z);
            x[8 * k + 6] = bf_lo(xv.w) + g0 * bf_lo(a.w) + g1 * bf_lo(b.w); x[8 * k + 7] = bf_hi(xv.w) + g0 * bf_hi(a.w) + g1 * bf_hi(b.w); }
        float ss = 0.f;
#pragma unroll
        for (int jj = 0; jj < 16; ++jj) ss += x[jj] * x[jj];
        ss = wave_sum(ss);
        const float rstd = rsqrtf(ss * (1.0f / 1024.0f) + EPS);
        if (last) { float o[16];
#pragma unroll
            for (int jj = 0; jj < 16; ++jj) o[jj] = x[jj] * rstd * gv[jj];
            row_store_f32(Xout + (size_t)row * 1024, lane, o); }
        else { row_store_bf16(X + (size_t)row * 1024, lane, x); if (lane == 0) rstd_arr[row] = rstd; }
        cur = nxt;
    }
}

enum { K_PREP = 0, K_A1, K_A2, K_A3, K_B1, K_B2, K_B3, K_B4, K_M1, K_M2, K_M3, K_M4 };
constexpr int NPHASES = 29;
__device__ __forceinline__ void phase_decode(int ph, int& kind, int& layer) {
    if (ph == 0) { kind = K_PREP; layer = 0; return; }
    const int q = ph - 1, pair = q / 14, off = q % 14;
    if (off < 7) { layer = 2 * pair; kind = off < 3 ? K_A1 + off : K_M1 + (off - 3); }
    else { layer = 2 * pair + 1; const int o = off - 7; kind = o == 0 ? K_B1 : o == 1 ? K_B2 : o == 2 ? K_B4 : K_M1 + (o - 3); }
}

__global__ void __launch_bounds__(NTHREADS, 2) mk(Params p_arg, int ph_lo, int ph_hi, int coop) {
    extern __shared__ __attribute__((aligned(16))) unsigned char smem[];
    LAS unsigned char* lds = (LAS unsigned char*)smem;
    volatile LAS unsigned* st = (volatile LAS unsigned*)(lds + LDS_MISC);
    if (threadIdx.x < 4) st[threadIdx.x] = 0u;
    __syncthreads();
    XcdBarrier bar; bar.bar = (unsigned*)(p_arg.ws + OFF_CTL); bar.x = 0; bar.st = st;
    if (ph_hi - ph_lo > 1) bar = xcd_barrier_post((unsigned*)(p_arg.ws + OFF_CTL), st);
#ifdef REP_KIND
    int rep_done = 0;
#endif
    for (int ph = ph_lo; ph < ph_hi; ++ph) {
        int kind, layer; phase_decode(ph, kind, layer);
        KP p = (KP)__builtin_amdgcn_kernarg_segment_ptr();
        int c = blockIdx.x, G = gridDim.x;
        asm volatile("" : "+s"(kind), "+s"(layer), "+s"(p), "+s"(c), "+s"(G));
        unsigned char* ws = p->ws;
        const int j = layer >> 1;
        switch (kind) {
        case K_PREP: phase_prep(lds, p, c, G); break;
        case K_A1: { GemmDesc g{(const bf16_t*)(ws + OFF_XB), (const bf16_t*)(ws + OFF_WAIN) + (size_t)j * 4096 * 1024, 1024, 1024, 1024, nullptr};
            DenseSched S; S.init(T_, 4096, G, c, 1024, 1024, 0);
            EpiAin E{(bf16_t*)(ws + OFF_Z), p->in[4] + j * 4096, (float*)(ws + OFF_VSS) + (size_t)j * T_ * 32, (const float*)(ws + OFF_RSTD)};
            gemm_phase<EpiAin, DenseSched, false>(lds, g, S, E);
            } break;
        case K_A2: phase_spatial(lds, p, j, c, G); break;
        case K_A3: { GemmDesc g{(const bf16_t*)(ws + OFF_YS), (const bf16_t*)(ws + OFF_WAOUT) + (size_t)j * 1024 * 2048, 2048, 2048, 2048, nullptr};
            DenseSched S; S.init(T_, 1024, G, c, 2048, 2048, 0);
            EpiResid E{(bf16_t*)(ws + OFF_XB), (float*)(ws + OFF_XSS)};
            gemm_phase<EpiResid, DenseSched, false>(lds, g, S, E); } break;
        case K_B1: { GemmDesc g{(const bf16_t*)(ws + OFF_XB), (const bf16_t*)(ws + OFF_WBIN) + (size_t)j * 1024 * 1024, 1024, 1024, 1024, nullptr};
            DenseSched S; S.init(T_, 1024, G, c, 1024, 1024, 0);
            EpiBf E{(bf16_t*)(ws + OFF_Z), 1024, nullptr, (const float*)(ws + OFF_RSTD)};
            gemm_phase<EpiBf, DenseSched, false>(lds, g, S, E); } break;
        case K_B2: phase_pool(p, c, G); break;
        case K_B4: { GemmDesc g{(const bf16_t*)(ws + OFF_Z) + (size_t)T_ * 1024, (const bf16_t*)(ws + OFF_WBOUT) + (size_t)j * 1024 * 1024, 1024, 1024, 1024, nullptr};
            DenseSched S; S.init(T_, 1024, G, c, 1024, 1024, 0);
            EpiResid E{(bf16_t*)(ws + OFF_XB), (float*)(ws + OFF_XSS)};
            gemm_phase<EpiResid, DenseSched, false>(lds, g, S, E); } break;
        case K_M1:
#ifdef PROBE_M1
            phase_router(lds, p, layer, c, G, layer + 4); xcd_barrier(bar);
#endif
            phase_router(lds, p, layer, c, G, layer); break;
        case K_M2: { GemmDesc g{(const bf16_t*)(ws + OFF_XB), (const bf16_t*)(ws + OFF_WGU) + (size_t)layer * 32 * 1024 * 1024, 1024, 1024, 1024, (const int*)(ws + OFF_LIST)};
            MoeSched S; S.init((const unsigned*)(ws + OFF_CTL) + CW_CNT + layer * 32 * 16, G, c, 0);
            EpiSwiglu E{(bf16_t*)(ws + OFF_Z), (const float*)(ws + OFF_RSS)};
            gemm_phase<EpiSwiglu, MoeSched, true>(lds, g, S, E); }
            if (layer == 0) {
                const int fb = G > 32 ? G - 32 : 0;
                if (c >= fb) {
                    int kf = 256; asm volatile("" : "+s"(kf));
                    GemmDesc gf{(const bf16_t*)(ws + OFF_WBT), (const bf16_t*)(ws + OFF_WBG), 1024, 256, kf, nullptr};
                    FoldSched SF{G - fb, c - fb}; EpiBf EF{(bf16_t*)(ws + OFF_WBOUT), 1024, nullptr, nullptr};
                    gemm_phase<EpiBf, FoldSched, false>(lds, gf, SF, EF); } }
            break;
        case K_M3: { GemmDesc g{(const bf16_t*)(ws + OFF_Z), (const bf16_t*)(ws + OFF_WDN) + (size_t)layer * 32 * 1024 * 512, 512, 512, 512, nullptr};
            MoeSched S; S.init((const unsigned*)(ws + OFF_CTL) + CW_CNT + layer * 32 * 16, G, c, 1);
            EpiBf E{(bf16_t*)(ws + OFF_Z + HID_BYTES), 1024, nullptr, nullptr};
            gemm_phase<EpiBf, MoeSched, false>(lds, g, S, E); } break;
        case K_M4:
#ifdef PROBE_M4
            phase_combine(p, layer == 3 ? 2 : layer, c, G, (float*)(ws + OFF_YS)); xcd_barrier(bar);
#endif
            phase_combine(p, layer, c, G, p->X); break;
        }
#ifdef REP_KIND
        if (kind == REP_KIND && rep_done < REP_N - 1) { ++rep_done; xcd_barrier(bar); --ph; continue; }
        rep_done = 0;
#endif
        if (ph + 1 < ph_hi) {
#if MK_CG_SYNC
            if (coop && ph == ph_lo) { cg::this_grid().sync(); } else
#endif
            xcd_barrier(bar);
        }
    }
}

extern "C" void kernel_launch(void* const* d_in, const int* in_sizes, int n_in, void* d_out, int out_size, void* d_ws, size_t ws_size, hipStream_t stream) {
    static int grid = 0;
    if (!grid) {
        if (n_in != 21 || out_size != T_ * DM || ws_size < WS_END) { fprintf(stderr, "kernel_launch: unexpected shapes (n_in %d out %d ws %zu need %zu)\n", n_in, out_size, ws_size, (size_t)WS_END); return; }
        int dev = 0, cus = 0, per_cu = 0;
        hipGetDevice(&dev); hipDeviceGetAttribute(&cus, hipDeviceAttributeMultiprocessorCount, dev);
        if (hipFuncSetAttribute((const void*)mk, hipFuncAttributeMaxDynamicSharedMemorySize, LDS_BYTES) != hipSuccess) { fprintf(stderr, "kernel_launch: hipFuncSetAttribute failed\n"); return; }
        hipOccupancyMaxActiveBlocksPerMultiprocessor(&per_cu, (const void*)mk, NTHREADS, LDS_BYTES);
        if (per_cu < 1) { fprintf(stderr, "kernel_launch: occupancy query says %d blocks per CU\n", per_cu); per_cu = 1; }
        grid = cus * 1;
        if (grid % 8) grid -= grid % 8;
    }
    hipMemsetAsync((char*)d_ws + OFF_CTL, 0, CTL_BYTES, stream);
    Params p; memset(&p, 0, sizeof(p));
    for (int i = 0; i < 21; ++i) p.in[i] = (const float*)d_in[i];
    p.X = (float*)d_out; p.ws = (unsigned char*)d_ws;
#if MK_SINGLE
    int lo = 0, hi = NPHASES, coop = 1;
    void* args[] = {&p, &lo, &hi, &coop};
    hipError_t e = hipLaunchCooperativeKernel((const void*)mk, dim3(grid), dim3(NTHREADS), args, LDS_BYTES, stream);
    if (e != hipSuccess) fprintf(stderr, "cooperative launch failed: %s (grid %d)\n", hipGetErrorString(e), grid);
#else
    for (int ph = 0; ph < NPHASES; ++ph) hipLaunchKernelGGL(mk, dim3(grid), dim3(NTHREADS), LDS_BYTES, stream, p, ph, ph + 1, 0);
#endif
}
```

```cpp
#include <hip/hip_runtime.h>
#include <hip/hip_cooperative_groups.h>
#include <cstdio>
#include <cstdint>
#include <cstring>
namespace cg = cooperative_groups;

#ifndef MK_SINGLE
#define MK_SINGLE 1
#endif

#ifndef MK_CG_SYNC
#define MK_CG_SYNC 0
#endif

#define LAS __attribute__((address_space(3)))
typedef unsigned short bf16_t;
typedef short bf16x8 __attribute__((ext_vector_type(8)));
typedef short s16x4 __attribute__((ext_vector_type(4)));
typedef float f32x4 __attribute__((ext_vector_type(4)));
typedef float f32x2 __attribute__((ext_vector_type(2)));
typedef unsigned u32x4 __attribute__((ext_vector_type(4)));
typedef unsigned u32x2 __attribute__((ext_vector_type(2)));
typedef int i32x4 __attribute__((ext_vector_type(4)));
typedef __bf16 bf16x2_t __attribute__((ext_vector_type(2)));

constexpr int T_ = 32768, DM = 1024, SEQ = 2048;
constexpr int NTHREADS = 512;
constexpr float EPS = 1e-6f;
constexpr int LIST_CAP = 32768;
constexpr int MAX_TILES = 288;

constexpr size_t CTL_BYTES = 65536;
constexpr size_t OFF_CTL = 0;
constexpr size_t OFF_VSS = OFF_CTL + CTL_BYTES;
constexpr size_t OFF_XSS = OFF_VSS + (size_t)2 * T_ * 32 * 4;
constexpr size_t OFF_LIST = OFF_XSS + (size_t)T_ * 16 * 4;
constexpr size_t OFF_SLOT = OFF_LIST + (size_t)32 * LIST_CAP * 4;
constexpr size_t OFF_GATE = OFF_SLOT + (size_t)T_ * 16;
constexpr size_t OFF_WAIN = OFF_GATE + (size_t)T_ * 8;
constexpr size_t OFF_WAOUT = OFF_WAIN + (size_t)2 * 4096 * 1024 * 2;
constexpr size_t OFF_WBIN = OFF_WAOUT + (size_t)2 * 1024 * 2048 * 2;
constexpr size_t OFF_WBG = OFF_WBIN + (size_t)2 * 1024 * 1024 * 2;
constexpr size_t OFF_WBOUT = OFF_WBG + (size_t)2 * 4 * 256 * 256 * 2;
constexpr size_t OFF_WBT = OFF_WBOUT + (size_t)2 * 1024 * 1024 * 2;
constexpr size_t OFF_WGU = OFF_WBT + (size_t)2 * 1024 * 1024 * 2;
constexpr size_t OFF_WDN = OFF_WGU + (size_t)128 * 1024 * 1024 * 2;
constexpr size_t OFF_H = OFF_WDN + (size_t)128 * 1024 * 512 * 2;
constexpr size_t OFF_Z = OFF_H + (size_t)T_ * 1024 * 2;
constexpr size_t OFF_YS = OFF_Z + (size_t)T_ * 4096 * 2;
constexpr size_t OFF_XB = OFF_YS + (size_t)T_ * 2048 * 2;
constexpr size_t OFF_RSTD = OFF_XB + (size_t)T_ * 1024 * 2;
constexpr size_t OFF_RSS = OFF_RSTD + (size_t)T_ * 4;
constexpr size_t WS_END = OFF_RSS + (size_t)32 * LIST_CAP * 4;
constexpr size_t HID_BYTES = (size_t)MAX_TILES * 256 * 512 * 2;
constexpr int CW_CNT = 4096;

constexpr int STAGE_BYTES = 131072;
constexpr int LDS_MISC = 148608;
constexpr int LDS_BYTES = 148608 + 1024;

struct Params {
    const float* in[21];
    float* X;
    unsigned char* ws;
};
typedef const __attribute__((address_space(4))) Params* KP;

#ifndef F8_LAYERS
#define F8_LAYERS 0xF
#endif
constexpr float F8_WSC = 64.f, F8_XSC = 4.f, F8_HSC = 4.f;
__device__ __forceinline__ unsigned pk_bf16(float lo, float hi) { f32x2 v = {lo, hi}; bf16x2_t b = __builtin_convertvector(v, bf16x2_t); return __builtin_bit_cast(unsigned, b); }
__device__ __forceinline__ unsigned pk_fp8x4(float a, float b, float c, float d) {
    a = __builtin_amdgcn_fmed3f(a, -448.f, 448.f); b = __builtin_amdgcn_fmed3f(b, -448.f, 448.f); c = __builtin_amdgcn_fmed3f(c, -448.f, 448.f); d = __builtin_amdgcn_fmed3f(d, -448.f, 448.f);
    int v = 0; v = __builtin_amdgcn_cvt_pk_fp8_f32(a, b, v, false); v = __builtin_amdgcn_cvt_pk_fp8_f32(c, d, v, true); return (unsigned)v; }
__device__ __forceinline__ float bf_lo(unsigned w) { return __uint_as_float(w << 16); }
__device__ __forceinline__ float bf_hi(unsigned w) { return __uint_as_float(w & 0xffff0000u); }
__device__ __forceinline__ int   lperm(int src, int v)   { return __builtin_amdgcn_ds_bpermute(src << 2, v); }
__device__ __forceinline__ float lperm(int src, float v) { return __int_as_float(__builtin_amdgcn_ds_bpermute(src << 2, __float_as_int(v))); }
__device__ __forceinline__ float wave_sum(float v, int lane) {
#pragma unroll
    for (int o = 32; o >= 1; o >>= 1) v += lperm(lane ^ o, v);
    return v;
}
__device__ __forceinline__ f32x2 gelu_pk(f32x2 v) {
    f32x2 c; c.x = __builtin_amdgcn_fmed3f(v.x, -4.5f, 4.5f); c.y = __builtin_amdgcn_fmed3f(v.y, -4.5f, 4.5f);
    const f32x2 s = c * c;
    f32x2 q = s * (-1.314259884e-12f) + 1.615359483e-10f;
    q = q * s + (-8.862621216e-09f); q = q * s + 2.885190317e-07f; q = q * s + (-6.266685043e-06f); q = q * s + 9.706125547e-05f;
    q = q * s + (-1.118662168e-03f); q = q * s + 9.821903153e-03f; q = q * s + (-6.632139887e-02f); q = q * s + 3.988761390e-01f;
    const f32x2 ph = c * q + 0.5f;
    return v * ph;
}
__device__ __forceinline__ float silu_f(float x) { return x * __builtin_amdgcn_rcpf(1.0f + __expf(-x)); }

extern __shared__ __attribute__((aligned(16))) unsigned char smem_tid[];
constexpr int LDS_WVTAB = LDS_MISC + 768;
__device__ __forceinline__ int hw_slot() { return (int)(__builtin_amdgcn_s_getreg((5 << 11) | 4) & 63u); }
__device__ __forceinline__ int tid_opaque() {
    int z = 0; asm volatile("" : "+v"(z));
    const int lane = (int)__builtin_amdgcn_mbcnt_hi(~0u, __builtin_amdgcn_mbcnt_lo(~0u, (unsigned)z));
    const int wv = __builtin_amdgcn_readfirstlane(*(volatile LAS int*)((LAS unsigned char*)smem_tid + LDS_WVTAB + hw_slot() * 4));
    int t = (wv << 6) | lane; asm volatile("" : "+v"(t)); return t; }

__device__ __forceinline__ size_t zoff(int row, int col) { return ((size_t)((row >> 7) * 16 + (col >> 8)) * 128 + (row & 127)) * 256 + (col & 255); }

constexpr int BM = 256, BK = 64, HALF = 128, HTB = HALF * BK * 2, NXCD = 8, WGM = 8;

__device__ __forceinline__ int lds_byte(int r, int c) { const int st = (r >> 4) * 2 + (c >> 5), rr = r & 15, cc = c & 31, ob = rr * 64 + cc * 2; return st * 1024 + (ob ^ (((ob >> 9) & 1) << 5)); }
__device__ __forceinline__ void stage_rc(int b, int& R, int& C) { const int st = b / 1024, sb = b % 1024, swz = sb ^ (((sb >> 9) & 1) << 5); R = (st >> 1) * 16 + swz / 64; C = (st & 1) * 32 + (swz % 64) / 2; }
__device__ __forceinline__ int perm32(int rho) { const int n = rho >> 4, i = rho & 15; return 8 * (i >> 2) + 4 * n + (i & 3); }

struct Unit { int orow, ocol; unsigned aoff, boff; int gbase, gcnt; };
struct GemmDesc { const bf16_t* A; const bf16_t* Bt; int lda, ldb, K; const int* list; };

struct DenseSched {
    int nM, nN, nwg, G, c; unsigned a_pm, a_pn, b_pn;
    __device__ void init(int M, int N, int G_, int c_, int lda, int ldb, unsigned a_pn_bytes) { nM = M / BM; nN = N / BM; nwg = nM * nN; G = G_; c = c_; a_pm = (unsigned)BM * lda * 2; a_pn = a_pn_bytes; b_pn = (unsigned)BM * ldb * 2; }
    __device__ __forceinline__ bool next(int i, Unit& u) const {
        const long L = (long)i * G + c; if (L >= nwg) return false;
        int wgid = (int)L; { const int q = nwg / NXCD, r = nwg % NXCD, xcd = wgid % NXCD, off = wgid / NXCD; wgid = (xcd < r ? xcd * (q + 1) : r * (q + 1) + (xcd - r) * q) + off; }
        const int nig = WGM * nN, gid = wgid / nig, fm = gid * WGM, gsz = (nM - fm) < WGM ? (nM - fm) : WGM;
        const int pm = fm + ((wgid % nig) % gsz), pn = (wgid % nig) / gsz;
        u.orow = pm * BM; u.ocol = pn * BM; u.aoff = pm * a_pm + pn * a_pn; u.boff = pn * b_pn; u.gbase = 0; u.gcnt = 0; return true;
    }
};
struct FoldSched {
    int G, c;
    __device__ __forceinline__ bool next(int i, Unit& u) const {
        const int L = i * G + c; if (L >= 32) return false;
        const int jl = L >> 4, g = (L >> 2) & 3, pm = L & 3;
        u.orow = jl * 1024 + pm * 256; u.ocol = g * 256; u.aoff = (unsigned)((jl * 1024 + pm * 256) * 1024 + g * 256) * 2u; u.boff = (unsigned)(jl * 4 + g) * 131072u; u.gbase = 0; u.gcnt = 0; return true;
    }
};
struct MoeSched {
    int G, c, ng, x, slot, nslots, mode, f8;
    int cnt_v, tiles_v, tb_v;
    __device__ void init(const unsigned* cnt, int G_, int c_, int mode_, int f8_ = 0) {
        G = G_; c = c_; mode = mode_; f8 = f8_; ng = (G % 8 == 0) ? 8 : 1; x = c % ng; slot = c / ng; nslots = G / ng;
        const int lane = tid_opaque() & 63;
        int cn = 0; if (lane < 32) cn = (int)__hip_atomic_load(cnt + lane * 16, __ATOMIC_RELAXED, __HIP_MEMORY_SCOPE_AGENT);
        const int tl = (cn + 255) >> 8; int v = tl;
#pragma unroll
        for (int d = 1; d < 32; d <<= 1) { const int t = lperm(lane - d, v); if (lane >= d) v += t; }
        cnt_v = cn; tiles_v = tl; tb_v = v - tl;
    }
    __device__ __forceinline__ bool next(int i, Unit& u) const {
        int v = i * nslots + slot;
        for (int e = x; e < 32; e += ng) {
            const int te = __builtin_amdgcn_readlane(tiles_v, e), ne = te * 4;
            if (v < ne) {
                const int jt = v % te, pn = v / te, tb = __builtin_amdgcn_readlane(tb_v, e), cn = __builtin_amdgcn_readlane(cnt_v, e);
                u.orow = (tb + jt) * 256; u.ocol = pn * 256;
                if (mode == 0) { u.aoff = 0; u.boff = ((unsigned)(e * 1024 + pn * 256) * 2048u) >> f8; u.gbase = e * LIST_CAP + jt * 256; u.gcnt = cn - jt * 256; }
                else { u.aoff = ((unsigned)(tb + jt) * 262144u) >> f8; u.boff = ((unsigned)(e * 1024 + pn * 256) * 1024u) >> f8; u.gbase = 0; u.gcnt = 0; }
                return true;
            }
            v -= ne;
        }
        return false;
    }
};

struct EpiAin {
    static constexpr bool PERM = true;
    bf16_t* Z; const float* bias; float* vss; const float* rstd;
    __device__ __forceinline__ void operator()(const f32x4 (&acc)[2][2][4][2], const Unit& u, int wr, int wc, int fr, int fq) const {
        const int row0 = u.orow + wr * 64 + fr, col0 = u.ocol + wc * 32 + 8 * fq; const bool vt = u.ocol >= 2048;
        f32x4 bv[2][2];
#pragma unroll
        for (int bj = 0; bj < 2; ++bj)
#pragma unroll
            for (int n = 0; n < 2; ++n) bv[bj][n] = *(const f32x4*)(bias + col0 + bj * HALF + 4 * n);
        float rsv[2][4];
#pragma unroll
        for (int ai = 0; ai < 2; ++ai)
#pragma unroll
            for (int m = 0; m < 4; ++m) rsv[ai][m] = rstd[row0 + ai * HALF + m * 16];
        if (vt) {
#pragma unroll
            for (int ai = 0; ai < 2; ++ai)
#pragma unroll
                for (int m = 0; m < 4; ++m) { const int row = row0 + ai * HALF + m * 16; bf16_t* rowp = Z + zoff(row, col0); float ss = 0.f; const float rs = rsv[ai][m];
#pragma unroll
                    for (int bj = 0; bj < 2; ++bj) { f32x4 v0 = acc[ai][bj][m][0] * rs + bv[bj][0], v1 = acc[ai][bj][m][1] * rs + bv[bj][1];
                        const f32x2 a = gelu_pk((f32x2){v0[0], v0[1]}), b = gelu_pk((f32x2){v0[2], v0[3]}), c = gelu_pk((f32x2){v1[0], v1[1]}), d = gelu_pk((f32x2){v1[2], v1[3]});
                        ss += (a.x * a.x + a.y * a.y) + (b.x * b.x + b.y * b.y) + (c.x * c.x + c.y * c.y) + (d.x * d.x + d.y * d.y);
                        u32x4 w; w.x = pk_bf16(a.x, a.y); w.y = pk_bf16(b.x, b.y); w.z = pk_bf16(c.x, c.y); w.w = pk_bf16(d.x, d.y);
                        *(u32x4*)(rowp + bj * HALF) = w; }
                    ss += lperm((fr | (fq << 4)) ^ 16, ss); ss += lperm((fr | (fq << 4)) ^ 32, ss); if (fq == 0) vss[(size_t)row * 32 + (((u.ocol - 2048) >> 8) * 4 + wc)] = ss; }
        } else {
#pragma unroll
            for (int ai = 0; ai < 2; ++ai)
#pragma unroll
                for (int m = 0; m < 4; ++m) { bf16_t* rowp = Z + zoff(row0 + ai * HALF + m * 16, col0); const float rs = rsv[ai][m];
#pragma unroll
                    for (int bj = 0; bj < 2; ++bj) { const f32x4 v0 = acc[ai][bj][m][0] * rs + bv[bj][0], v1 = acc[ai][bj][m][1] * rs + bv[bj][1];
                        u32x4 w; w.x = pk_bf16(v0[0], v0[1]); w.y = pk_bf16(v0[2], v0[3]); w.z = pk_bf16(v1[0], v1[1]); w.w = pk_bf16(v1[2], v1[3]);
                        *(u32x4*)(rowp + bj * HALF) = w; } }
        }
    }
};
struct EpiResid {
    static constexpr bool PERM = true;
    bf16_t* XB; float* xss;
    __device__ __forceinline__ void operator()(const f32x4 (&acc)[2][2][4][2], const Unit& u, int wr, int wc, int fr, int fq) const {
        const int row0 = u.orow + wr * 64 + fr, col0 = u.ocol + wc * 32 + 8 * fq;
#pragma unroll
        for (int ai = 0; ai < 2; ++ai) {
            __builtin_amdgcn_sched_barrier(0);
            u32x4 res[4][2];
#pragma unroll
            for (int m = 0; m < 4; ++m) { const bf16_t* inp = XB + (size_t)(row0 + ai * HALF + m * 16) * 1024 + col0;
#pragma unroll
                for (int bj = 0; bj < 2; ++bj) res[m][bj] = *(const u32x4*)(inp + bj * HALF); }
#pragma unroll
            for (int m = 0; m < 4; ++m) { const int row = row0 + ai * HALF + m * 16; bf16_t* rowp = XB + (size_t)row * 1024 + col0; float ss = 0.f;
#pragma unroll
                for (int bj = 0; bj < 2; ++bj) { const u32x4 r = res[m][bj]; const f32x4 a0 = acc[ai][bj][m][0], a1 = acc[ai][bj][m][1];
                    u32x4 w; w.x = pk_bf16(bf_lo(r.x) + a0[0], bf_hi(r.x) + a0[1]); w.y = pk_bf16(bf_lo(r.y) + a0[2], bf_hi(r.y) + a0[3]);
                    w.z = pk_bf16(bf_lo(r.z) + a1[0], bf_hi(r.z) + a1[1]); w.w = pk_bf16(bf_lo(r.w) + a1[2], bf_hi(r.w) + a1[3]);
                    *(u32x4*)(rowp + bj * HALF) = w;
                    const float v0 = bf_lo(w.x), v1 = bf_hi(w.x), v2 = bf_lo(w.y), v3 = bf_hi(w.y), v4 = bf_lo(w.z), v5 = bf_hi(w.z), v6 = bf_lo(w.w), v7 = bf_hi(w.w);
                    ss += ((v0 * v0 + v1 * v1) + (v2 * v2 + v3 * v3)) + ((v4 * v4 + v5 * v5) + (v6 * v6 + v7 * v7)); }
                ss += lperm((fr | (fq << 4)) ^ 16, ss); ss += lperm((fr | (fq << 4)) ^ 32, ss);
                if (fq == 0) xss[(size_t)row * 16 + (u.ocol >> 8) * 4 + wc] = ss; }
        }
    }
};
struct EpiBf {
    static constexpr bool PERM = true;
    bf16_t* O; int ldc; const float* scale; const float* rowscale;
    float cs = 1.0f;
    __device__ __forceinline__ void operator()(const f32x4 (&acc)[2][2][4][2], const Unit& u, int wr, int wc, int fr, int fq) const {
        const int row0 = u.orow + wr * 64 + fr, col0 = u.ocol + wc * 32 + 8 * fq;
        float rsv[2][4];
#pragma unroll
        for (int ai = 0; ai < 2; ++ai)
#pragma unroll
            for (int m = 0; m < 4; ++m) rsv[ai][m] = (rowscale ? rowscale[row0 + ai * HALF + m * 16] : 1.0f) * cs;
#pragma unroll
        for (int ai = 0; ai < 2; ++ai)
#pragma unroll
            for (int m = 0; m < 4; ++m) { bf16_t* rowp = O + (size_t)(row0 + ai * HALF + m * 16) * ldc + col0;
                asm volatile("" ::: "memory");
                const float rs = rsv[ai][m];
#pragma unroll
                for (int bj = 0; bj < 2; ++bj) { f32x4 v0 = acc[ai][bj][m][0] * rs, v1 = acc[ai][bj][m][1] * rs;
                    if (scale) { v0 = v0 * *(const f32x4*)(scale + col0 + bj * HALF); v1 = v1 * *(const f32x4*)(scale + col0 + bj * HALF + 4); }
                    u32x4 w; w.x = pk_bf16(v0[0], v0[1]); w.y = pk_bf16(v0[2], v0[3]); w.z = pk_bf16(v1[0], v1[1]); w.w = pk_bf16(v1[2], v1[3]);
                    *(u32x4*)(rowp + bj * HALF) = w; } }
    }
};
struct EpiY8 {
    static constexpr bool PERM = true;
    bf16_t* O; float cs;
    __device__ __forceinline__ void operator()(const f32x4 (&acc)[2][2][4][2], const Unit& u, int wr, int wc, int, int) const {
        int z = 0; asm volatile("" : "+v"(z));
        const int ln = (int)__builtin_amdgcn_mbcnt_hi(~0u, __builtin_amdgcn_mbcnt_lo(~0u, (unsigned)z)), fr = ln & 15, fq = ln >> 4;
        bf16_t* base = O + (size_t)(u.orow + wr * 64 + fr) * 1024 + u.ocol + wc * 32 + 8 * fq;
#pragma unroll
        for (int ai = 0; ai < 2; ++ai)
#pragma unroll
            for (int m = 0; m < 4; ++m) { bf16_t* rowp = base + (size_t)(ai * HALF + m * 16) * 1024;
#pragma unroll
                for (int bj = 0; bj < 2; ++bj) { const f32x4 v0 = acc[ai][bj][m][0] * cs, v1 = acc[ai][bj][m][1] * cs;
                    u32x4 w; w.x = pk_bf16(v0[0], v0[1]); w.y = pk_bf16(v0[2], v0[3]); w.z = pk_bf16(v1[0], v1[1]); w.w = pk_bf16(v1[2], v1[3]);
                    *(u32x4*)(rowp + bj * HALF) = w; } }
    }
};
struct EpiSwiglu8 {
    static constexpr bool PERM = true;
    unsigned char* HID8; float cin;
    __device__ __forceinline__ void operator()(const f32x4 (&acc)[2][2][4][2], const Unit& u, int wr, int wc, int, int) const {
        int z = 0; asm volatile("" : "+v"(z));
        const int ln = (int)__builtin_amdgcn_mbcnt_hi(~0u, __builtin_amdgcn_mbcnt_lo(~0u, (unsigned)z)), fr = ln & 15, fq = ln >> 4;
        const int row0 = u.orow + wr * 64 + fr, col0 = (u.ocol >> 1) + wc * 32 + 8 * fq, ri0 = wr * 64 + fr;
#pragma unroll
        for (int ai = 0; ai < 2; ++ai)
#pragma unroll
            for (int m = 0; m < 4; ++m) { const int idx = ri0 + ai * HALF + m * 16; const float r = idx < u.gcnt ? cin : 0.f;
                unsigned char* rowp = HID8 + (size_t)(row0 + ai * HALF + m * 16) * 512 + col0;
                const f32x4 g0 = acc[ai][0][m][0] * r, g1 = acc[ai][0][m][1] * r, u0 = acc[ai][1][m][0] * (r * F8_HSC), u1 = acc[ai][1][m][1] * (r * F8_HSC);
                u32x2 w; w.x = pk_fp8x4(silu_f(g0[0]) * u0[0], silu_f(g0[1]) * u0[1], silu_f(g0[2]) * u0[2], silu_f(g0[3]) * u0[3]);
                w.y = pk_fp8x4(silu_f(g1[0]) * u1[0], silu_f(g1[1]) * u1[1], silu_f(g1[2]) * u1[2], silu_f(g1[3]) * u1[3]);
                *(u32x2*)rowp = w; }
    }
};
struct EpiSwiglu {
    static constexpr bool PERM = true;
    bf16_t* HID; const float* rss;
    __device__ __forceinline__ void operator()(const f32x4 (&acc)[2][2][4][2], const Unit& u, int wr, int wc, int fr, int fq) const {
        const int row0 = u.orow + wr * 64 + fr, col0 = (u.ocol >> 1) + wc * 32 + 8 * fq, ri0 = wr * 64 + fr;
        float rs[2][4];
#pragma unroll
        for (int ai = 0; ai < 2; ++ai)
#pragma unroll
            for (int m = 0; m < 4; ++m) { const int idx = ri0 + ai * HALF + m * 16; rs[ai][m] = idx < u.gcnt ? rss[u.gbase + idx] : 0.f; }
#pragma unroll
        for (int ai = 0; ai < 2; ++ai)
#pragma unroll
            for (int m = 0; m < 4; ++m) { bf16_t* rowp = HID + (size_t)(row0 + ai * HALF + m * 16) * 512 + col0; const float r = rs[ai][m];
                const f32x4 g0 = acc[ai][0][m][0] * r, g1 = acc[ai][0][m][1] * r, u0 = acc[ai][1][m][0] * r, u1 = acc[ai][1][m][1] * r;
                u32x4 w; w.x = pk_bf16(silu_f(g0[0]) * u0[0], silu_f(g0[1]) * u0[1]); w.y = pk_bf16(silu_f(g0[2]) * u0[2], silu_f(g0[3]) * u0[3]);
                w.z = pk_bf16(silu_f(g1[0]) * u1[0], silu_f(g1[1]) * u1[1]); w.w = pk_bf16(silu_f(g1[2]) * u1[2], silu_f(g1[3]) * u1[3]);
                *(u32x4*)rowp = w; }
    }
};

typedef long i64_t;
typedef i64_t i64x2 __attribute__((ext_vector_type(2)));
template <class Epi, class Sched, bool GATHER, bool F8 = false>
__device__ __forceinline__ void gemm_phase(LAS unsigned char* lds, const GemmDesc g, const Sched& S, const Epi& E) {
    const int tid = tid_opaque(), wid = __builtin_amdgcn_readfirstlane(tid >> 6), lane = tid & 63, wr = wid >> 2, wc = wid & 3, fr = lane & 15, fq = lane >> 4;
    const int K = g.K, nt = K / BK;
    unsigned voffB[2];
#pragma unroll
    for (int i = 0; i < 2; ++i) { int R, C; stage_rc(tid * 16 + i * 8192, R, C); const int Rb = Epi::PERM ? ((R & ~31) + perm32(R & 31)) : R; voffB[i] = (unsigned)(Rb * g.ldb + C) * 2u; }
    const size_t kstep = (size_t)(BK * 2);
    const size_t hstepB = (size_t)HALF * g.ldb * 2;
    const unsigned ldsw = (unsigned)wid * 1024u;
    const int aoff = lds_byte(wr * 64 + fr, fq * 8), boff = lds_byte(wc * 32 + fr, fq * 8);
    auto setA = [&](unsigned (&v)[2][2], const Unit& u) {
#pragma unroll
        for (int i = 0; i < 2; ++i) { int R, C; stage_rc(tid * 16 + i * 8192, R, C);
#pragma unroll
            for (int h = 0; h < 2; ++h) { const int idx = h * HALF + R;
                if constexpr (GATHER) { const int tok = idx < u.gcnt ? g.list[u.gbase + idx] : 0; v[h][i] = ((unsigned)tok * (unsigned)g.lda + (unsigned)C) * 2u; }
                else v[h][i] = ((unsigned)idx * (unsigned)g.lda + (unsigned)C) * 2u; } }
    };
#define PG_SA(b, h) (((b) * 2 + (h)) * HTB)
#define PG_SB(b, h) ((4 + (b) * 2 + (h)) * HTB)
#define PG_STAGE(bufoff, gbase, voff) do { _Pragma("unroll") for (int _i = 0; _i < 2; ++_i) \
        __builtin_amdgcn_global_load_lds((const unsigned*)((const char*)(gbase) + (voff)[_i]), (LAS unsigned*)(lds + (bufoff) + ldsw + _i * 8192), 16, 0, 0); } while (0)
#define PG_LDA(dst, b, h) do { _Pragma("unroll") for (int m = 0; m < 4; ++m) _Pragma("unroll") for (int k = 0; k < 2; ++k) dst[m][k] = *(const LAS bf16x8*)(lds + PG_SA(b, h) + aoff + m * 2048 + k * 1024); } while (0)
#define PG_LDB(dst, b, h) do { _Pragma("unroll") for (int n = 0; n < 2; ++n) _Pragma("unroll") for (int k = 0; k < 2; ++k) dst[n][k] = *(const LAS bf16x8*)(lds + PG_SB(b, h) + boff + n * 2048 + k * 1024); } while (0)
#define PG_MMA(ai, bj, At, Bt) do { __builtin_amdgcn_s_setprio(1); _Pragma("unroll") for (int m = 0; m < 4; ++m) _Pragma("unroll") for (int n = 0; n < 2; ++n) _Pragma("unroll") for (int k = 0; k < 2; ++k) { \
        if constexpr (F8) { const i64x2 _b = __builtin_bit_cast(i64x2, Bt[n][k]), _a = __builtin_bit_cast(i64x2, At[m][k]); \
            acc[ai][bj][m][n] = __builtin_amdgcn_mfma_f32_16x16x32_fp8_fp8(_b.x, _a.x, acc[ai][bj][m][n], 0, 0, 0); \
            acc[ai][bj][m][n] = __builtin_amdgcn_mfma_f32_16x16x32_fp8_fp8(_b.y, _a.y, acc[ai][bj][m][n], 0, 0, 0); } \
        else acc[ai][bj][m][n] = __builtin_amdgcn_mfma_f32_16x16x32_bf16(Bt[n][k], At[m][k], acc[ai][bj][m][n], 0, 0, 0); } __builtin_amdgcn_s_setprio(0); } while (0)
#define PG_WAIT_V(n) asm volatile("s_waitcnt vmcnt(" #n ")" ::: "memory")
#define PG_WAIT_L(n) asm volatile("s_waitcnt lgkmcnt(" #n ")" ::: "memory")
#define PG_BAR __builtin_amdgcn_s_barrier()
#define PG_SCHED __builtin_amdgcn_sched_barrier(0)
    Unit cur, nxt; int ui = 0;
    if (!S.next(0, cur)) return;
    f32x4 acc[2][2][4][2];
#pragma unroll
    for (int a = 0; a < 2; ++a)
#pragma unroll
        for (int b = 0; b < 2; ++b)
#pragma unroll
            for (int m = 0; m < 4; ++m)
#pragma unroll
                for (int n = 0; n < 2; ++n) acc[a][b][m][n] = (f32x4){0.f, 0.f, 0.f, 0.f};
    bf16x8 At[4][2], B0[2][2], B1[2][2];
    unsigned va[2][2];
    setA(va, cur);
    const char* cA = (const char*)g.A + cur.aoff; const char* cB = (const char*)g.Bt + cur.boff;
    PG_STAGE(PG_SB(0, 0), cB, voffB); PG_STAGE(PG_SB(0, 1), cB + hstepB, voffB); PG_STAGE(PG_SA(0, 0), cA, va[0]); PG_STAGE(PG_SA(0, 1), cA, va[1]);
    if (wr == 1) PG_BAR;
    PG_WAIT_V(2); PG_BAR;
    PG_STAGE(PG_SB(1, 0), cB + kstep, voffB); PG_STAGE(PG_SA(1, 0), cA + kstep, va[0]); PG_STAGE(PG_SB(1, 1), cB + hstepB + kstep, voffB);
    PG_WAIT_V(6); PG_BAR;
    for (;;) {
        const bool has_next = S.next(ui + 1, nxt);
        const char* nA = has_next ? (const char*)g.A + nxt.aoff : cA; const char* nB = has_next ? (const char*)g.Bt + nxt.boff : cB;
        for (int t = 0; t < nt; t += 2) {
            const bool last = (t == nt - 2);
            const char* a1 = cA + (size_t)(t + 1) * kstep;
            const char* a2 = last ? nA : cA + (size_t)(t + 2) * kstep; const char* b2 = last ? nB : cB + (size_t)(t + 2) * kstep;
            const char* a3 = a2 + kstep; const char* b3 = b2 + kstep;
            PG_LDB(B0, 0, 0); PG_LDB(B1, 0, 1); PG_SCHED; PG_LDA(At, 0, 0); PG_STAGE(PG_SA(1, 1), a1, va[1]);
            PG_WAIT_V(8); PG_WAIT_L(0); PG_BAR; PG_MMA(0, 0, At, B0); PG_MMA(0, 1, At, B1); PG_BAR; PG_SCHED;
            if constexpr (GATHER) { if (last && has_next) setA(va, nxt); }
            PG_LDA(At, 0, 1); PG_STAGE(PG_SB(0, 0), b2, voffB); PG_STAGE(PG_SB(0, 1), b2 + hstepB, voffB); PG_STAGE(PG_SA(0, 0), a2, va[0]);
            PG_WAIT_V(8); PG_WAIT_L(0); PG_BAR; PG_MMA(1, 0, At, B0); PG_MMA(1, 1, At, B1); PG_BAR; PG_SCHED;
            PG_LDB(B0, 1, 0); PG_LDB(B1, 1, 1); PG_SCHED; PG_LDA(At, 1, 0); PG_STAGE(PG_SA(0, 1), a2, va[1]);
            PG_WAIT_V(8); PG_WAIT_L(0); PG_BAR; PG_MMA(0, 0, At, B0); PG_MMA(0, 1, At, B1); PG_BAR; PG_SCHED;
            PG_LDA(At, 1, 1); PG_STAGE(PG_SB(1, 0), b3, voffB); PG_STAGE(PG_SB(1, 1), b3 + hstepB, voffB); PG_STAGE(PG_SA(1, 0), a3, va[0]);
            PG_WAIT_V(8); PG_WAIT_L(0); PG_BAR; PG_MMA(1, 0, At, B0); PG_MMA(1, 1, At, B1); PG_BAR; PG_SCHED;
        }
        if (wr == 0) PG_BAR;
        E(acc, cur, wr, wc, fr, fq);
        if (!has_next) break;
#pragma unroll
        for (int a = 0; a < 2; ++a)
#pragma unroll
            for (int b = 0; b < 2; ++b)
#pragma unroll
                for (int m = 0; m < 4; ++m)
#pragma unroll
                    for (int n = 0; n < 2; ++n) acc[a][b][m][n] = (f32x4){0.f, 0.f, 0.f, 0.f};
        cur = nxt; cA = nA; cB = nB; ++ui;
        if (wr == 1) PG_BAR;
    }
    PG_WAIT_V(0);
    PG_BAR;
#undef PG_SA
#undef PG_SB
#undef PG_STAGE
#undef PG_LDA
#undef PG_LDB
#undef PG_MMA
#undef PG_WAIT_V
#undef PG_WAIT_L
#undef PG_BAR
#undef PG_SCHED
}

#define XB_TMO      128
#define XB_XCNT(j)  (256  + 64 * (j))
#define XB_XSUB(j)  (1280 + 64 * (j))
#define XB_XGEN(j)  (2304 + 64 * (j))
#define XB_TOP      3328
#define XB_TOPGEN   3392
#define XCD_BAR_WORDS 3456
#define XB_SPIN_CAP (1u << 22)
__device__ __forceinline__ unsigned xb_ld(unsigned* p)              { return __hip_atomic_load(p, __ATOMIC_RELAXED, __HIP_MEMORY_SCOPE_AGENT); }
__device__ __forceinline__ unsigned xb_add(unsigned* p, unsigned v) { return __hip_atomic_fetch_add(p, v, __ATOMIC_RELAXED, __HIP_MEMORY_SCOPE_AGENT); }
__device__ __forceinline__ unsigned xb_xcc_id() { return (unsigned)__builtin_amdgcn_s_getreg((3 << 11) | 20) & 0xFu; }
#define XB_SPIN(cond, bar) do { unsigned _sp = 0; while (cond) { __builtin_amdgcn_s_sleep(1); \
    if ((++_sp & 255u) == 0u) { if (xb_ld(&(bar)[XB_TMO])) break; if (_sp > XB_SPIN_CAP) { atomicAdd(&(bar)[XB_TMO], 1u); break; } } } } while (0)
struct XcdBarrier { unsigned* bar; unsigned x; volatile LAS unsigned* st; };
__device__ __forceinline__ XcdBarrier xcd_barrier_post(unsigned* bar, volatile LAS unsigned* st) {
    XcdBarrier b; b.bar = bar; b.x = xb_xcc_id(); b.st = st;
    if (tid_opaque() == 0) (void)xb_add(&bar[XB_XCNT(b.x)], 1u);
    return b;
}
__device__ __forceinline__ void xcd_barrier_complete(unsigned* bar, unsigned x, unsigned& nloc, unsigned& nx) {
    const unsigned G = gridDim.x * gridDim.y * gridDim.z;
    unsigned sum, cnt, mine, sp = 0u;
    for (;;) {
        sum = 0u; cnt = 0u; mine = 0u;
#pragma unroll
        for (unsigned j = 0; j < 16; ++j) { const unsigned c = xb_ld(&bar[XB_XCNT(j)]); sum += c; cnt += (c > 0u) ? 1u : 0u; mine = (j == x) ? c : mine; }
        if (sum == G) break;
        __builtin_amdgcn_s_sleep(1);
        if ((++sp & 255u) == 0u) { if (xb_ld(&bar[XB_TMO])) break; if (sp > XB_SPIN_CAP) { atomicAdd(&bar[XB_TMO], 1u); break; } }
    }
    nloc = mine > 0u ? mine : 1u; nx = cnt > 0u ? cnt : 1u;
}
__device__ __forceinline__ void xcd_barrier(const XcdBarrier& b) {
    asm volatile("s_waitcnt vmcnt(0)" ::: "memory");
    __syncthreads();
    if (tid_opaque() == 0) {
        unsigned* bar = b.bar;
        __builtin_amdgcn_s_waitcnt(0);
        unsigned nloc = b.st[0], nx = b.st[1];
        if (nloc == 0u) { xcd_barrier_complete(bar, b.x, nloc, nx); b.st[0] = nloc; b.st[1] = nx; }
        const unsigned old = xb_add(&bar[XB_XSUB(b.x)], 1u);
        const unsigned gen = old / nloc;
        if (old + 1u == (gen + 1u) * nloc) {
            __builtin_amdgcn_fence(__ATOMIC_RELEASE, "agent");
            asm volatile("s_waitcnt vmcnt(0)" ::: "memory");
            const unsigned og = xb_add(&bar[XB_TOP], 1u);
            const unsigned tg = og / nx;
            if (og + 1u == (tg + 1u) * nx) xb_add(&bar[XB_TOPGEN], 1u);
            else XB_SPIN(xb_ld(&bar[XB_TOPGEN]) == tg, bar);
            __builtin_amdgcn_fence(__ATOMIC_ACQUIRE, "agent");
            xb_add(&bar[XB_XGEN(b.x)], 1u);
            asm volatile("s_waitcnt vmcnt(0)" ::: "memory");
        } else {
            XB_SPIN(xb_ld(&bar[XB_XGEN(b.x)]) == gen, bar);
            __builtin_amdgcn_fence(__ATOMIC_ACQUIRE, "agent");
            asm volatile("s_waitcnt vmcnt(0)" ::: "memory");
        }
    }
    __syncthreads();
}

__device__ __forceinline__ void row_load_f32(const float* rowp, int lane, float (&v)[16]) {
#pragma unroll
    for (int k = 0; k < 2; ++k) { const f32x4 a = *(const f32x4*)(rowp + 512 * k + 8 * lane), b = *(const f32x4*)(rowp + 512 * k + 8 * lane + 4);
#pragma unroll
        for (int j = 0; j < 4; ++j) { v[8 * k + j] = a[j]; v[8 * k + 4 + j] = b[j]; } }
}
__device__ __forceinline__ void row_store_f32(float* rowp, int lane, const float (&v)[16]) {
#pragma unroll
    for (int k = 0; k < 2; ++k) { *(f32x4*)(rowp + 512 * k + 8 * lane) = (f32x4){v[8 * k], v[8 * k + 1], v[8 * k + 2], v[8 * k + 3]}; *(f32x4*)(rowp + 512 * k + 8 * lane + 4) = (f32x4){v[8 * k + 4], v[8 * k + 5], v[8 * k + 6], v[8 * k + 7]}; }
}
__device__ __forceinline__ void row_store_bf16(bf16_t* rowp, int lane, const float (&v)[16]) {
#pragma unroll
    for (int k = 0; k < 2; ++k) { u32x4 w; w.x = pk_bf16(v[8 * k], v[8 * k + 1]); w.y = pk_bf16(v[8 * k + 2], v[8 * k + 3]); w.z = pk_bf16(v[8 * k + 4], v[8 * k + 5]); w.w = pk_bf16(v[8 * k + 6], v[8 * k + 7]);
        *(u32x4*)(rowp + 512 * k + 8 * lane) = w; }
}
__device__ __forceinline__ void row_load_bf16(const bf16_t* rowp, int lane, float (&v)[16]) {
#pragma unroll
    for (int k = 0; k < 2; ++k) { const u32x4 w = *(const u32x4*)(rowp + 512 * k + 8 * lane);
        v[8 * k] = bf_lo(w.x); v[8 * k + 1] = bf_hi(w.x); v[8 * k + 2] = bf_lo(w.y); v[8 * k + 3] = bf_hi(w.y); v[8 * k + 4] = bf_lo(w.z); v[8 * k + 5] = bf_hi(w.z); v[8 * k + 6] = bf_lo(w.w); v[8 * k + 7] = bf_hi(w.w); }
}
__device__ __forceinline__ void row_rmsnorm(const float (&x)[16], const float* g, int lane, float (&o)[16]) {
    float ss = 0.f;
#pragma unroll
    for (int j = 0; j < 16; ++j) ss += x[j] * x[j];
    ss = wave_sum(ss, lane);
    const float rstd = rsqrtf(ss * (1.0f / 1024.0f) + EPS);
    float gv[16]; row_load_f32(g, lane, gv);
#pragma unroll
    for (int j = 0; j < 16; ++j) o[j] = x[j] * rstd * gv[j];
}

struct CvtJob { const float* src; bf16_t* dst; const float* kscale; int N, K, f8; };
constexpr int NT_AIN = 2048, NT_AOUT = 1024, NT_BIN = 512, NT_BOUT = 512, NT_G = 16384, NT_U = 16384, NT_D = 16384;
constexpr int NT_TOTAL = NT_AIN + NT_AOUT + NT_BIN + NT_BOUT + NT_G + NT_U + NT_D;
__device__ __forceinline__ void cvt_decode(KP p, int r, CvtJob& jb) {
    unsigned char* ws = p->ws; const float* src; int N, K; bf16_t* dst; int tk, tn, drow; jb.kscale = nullptr; jb.f8 = 0; unsigned char* d8 = nullptr;
    if (r < NT_AIN) { const int m = r >> 10, q = r & 1023; K = 1024; N = 4096; tk = q >> 6; tn = q & 63; src = p->in[3] + (size_t)m * K * N; dst = (bf16_t*)(ws + OFF_WAIN) + (size_t)m * N * K; drow = tn * 64; jb.kscale = p->in[1] + (2 * m) * 1024 + tk * 64; }
    else if ((r -= NT_AIN) < NT_AOUT) { const int m = r >> 9, q = r & 511; K = 2048; N = 1024; tk = q >> 4; tn = q & 15; src = p->in[8] + (size_t)m * K * N; dst = (bf16_t*)(ws + OFF_WAOUT) + (size_t)m * N * K; drow = tn * 64; }
    else if ((r -= NT_AOUT) < NT_BIN) { const int m = r >> 8, q = r & 255; K = 1024; N = 1024; tk = q >> 4; tn = q & 15; src = p->in[9] + (size_t)m * K * N; dst = (bf16_t*)(ws + OFF_WBIN) + (size_t)m * N * K; drow = tn * 64; jb.kscale = p->in[1] + (2 * m + 1) * 1024 + tk * 64; }
    else if ((r -= NT_BIN) < NT_BOUT) { const int m = r >> 8, q = r & 255; K = 1024; N = 1024; tk = q >> 4; tn = q & 15; src = p->in[12] + (size_t)m * K * N; dst = (bf16_t*)(ws + OFF_WBT) + (size_t)m * N * K; drow = tn * 64; }
    else if ((r -= NT_BOUT) < NT_G + NT_U) { const int up = r >= NT_G; if (up) r -= NT_G; const int m = r >> 7, q = r & 127; K = 1024; N = 512; tk = q >> 3; tn = q & 7;
        src = p->in[up ? 18 : 17] + (size_t)m * K * N; dst = (bf16_t*)(ws + OFF_WGU) + (size_t)m * 1024 * 1024; const int n0 = tn * 64; drow = (n0 >> 7) * 256 + (n0 & 127) + (up ? 128 : 0); jb.kscale = p->in[2] + (m >> 5) * 1024 + tk * 64;
        if ((F8_LAYERS >> (m >> 5)) & 1) { jb.f8 = 1; d8 = ws + OFF_WGU + (size_t)(m >> 5) * (64u << 20) + (size_t)(m & 31) * (1u << 20) + (size_t)drow * 1024 + tk * 64; } }
    else { r -= NT_G + NT_U; const int m = r >> 7, q = r & 127; K = 512; N = 1024; tk = q >> 4; tn = q & 15; src = p->in[19] + (size_t)m * K * N; dst = (bf16_t*)(ws + OFF_WDN) + (size_t)m * N * K; drow = tn * 64;
        if ((F8_LAYERS >> (m >> 5)) & 1) { jb.f8 = 1; d8 = ws + OFF_WDN + (size_t)(m >> 5) * (32u << 20) + (size_t)(m & 31) * (512u << 10) + (size_t)drow * 512 + tk * 64; } }
    jb.src = src + (size_t)(tk * 64) * N + tn * 64; jb.dst = jb.f8 ? (bf16_t*)d8 : dst + (size_t)drow * K + tk * 64; jb.N = N; jb.K = K;
}
__device__ void phase_prep(LAS unsigned char* lds, KP p, int c, int G) {
    const int tid = tid_opaque();
    const int n4 = tid & 15, kp = tid >> 4, rn = tid >> 3, cc = tid & 7;
    constexpr int NB = 4;
    CvtJob cur[NB], nxt[NB]; f32x4 a[NB], b[NB], na[NB], nb[NB];
    float k0 = 1.f, k1 = 1.f, nk0 = 1.f, nk1 = 1.f;
#pragma unroll
    for (int q = 0; q < NB; ++q) { const int t = c * NB + q; if (t < NT_TOTAL) { cvt_decode(p, t, cur[q]); a[q] = __builtin_nontemporal_load((const f32x4*)(cur[q].src + (size_t)(2 * kp) * cur[q].N + 4 * n4)); b[q] = __builtin_nontemporal_load((const f32x4*)(cur[q].src + (size_t)(2 * kp + 1) * cur[q].N + 4 * n4)); } }
    if (c * NB < NT_TOTAL && cur[0].kscale) { k0 = cur[0].kscale[2 * kp]; k1 = cur[0].kscale[2 * kp + 1]; }
    int buf = 0;
    for (int t0 = c * NB; t0 < NT_TOTAL; t0 += NB * G) {
#pragma unroll
        for (int q = 0; q < NB; ++q) if (t0 + q < NT_TOTAL) {
            LAS unsigned* L = (LAS unsigned*)(lds + (buf * NB + q) * 8704);
            const f32x4 av = a[q] * k0, bv = b[q] * k1;
#pragma unroll
            for (int jj = 0; jj < 4; ++jj) L[(4 * n4 + jj) * 33 + kp] = pk_bf16(av[jj], bv[jj]); }
        nk0 = 1.f; nk1 = 1.f;
#pragma unroll
        for (int q = 0; q < NB; ++q) { const int t = t0 + NB * G + q; if (t < NT_TOTAL) { cvt_decode(p, t, nxt[q]); na[q] = __builtin_nontemporal_load((const f32x4*)(nxt[q].src + (size_t)(2 * kp) * nxt[q].N + 4 * n4)); nb[q] = __builtin_nontemporal_load((const f32x4*)(nxt[q].src + (size_t)(2 * kp + 1) * nxt[q].N + 4 * n4)); } }
        if (t0 + NB * G < NT_TOTAL && nxt[0].kscale) { nk0 = nxt[0].kscale[2 * kp]; nk1 = nxt[0].kscale[2 * kp + 1]; }
        __syncthreads();
#pragma unroll
        for (int q = 0; q < NB; ++q) if (t0 + q < NT_TOTAL) {
            LAS unsigned* L = (LAS unsigned*)(lds + (buf * NB + q) * 8704);
            u32x4 w; w.x = L[rn * 33 + 4 * cc]; w.y = L[rn * 33 + 4 * cc + 1]; w.z = L[rn * 33 + 4 * cc + 2]; w.w = L[rn * 33 + 4 * cc + 3];
            if (cur[q].f8) { u32x2 b8; b8.x = pk_fp8x4(bf_lo(w.x) * F8_WSC, bf_hi(w.x) * F8_WSC, bf_lo(w.y) * F8_WSC, bf_hi(w.y) * F8_WSC); b8.y = pk_fp8x4(bf_lo(w.z) * F8_WSC, bf_hi(w.z) * F8_WSC, bf_lo(w.w) * F8_WSC, bf_hi(w.w) * F8_WSC);
                __builtin_nontemporal_store(b8, (u32x2*)((unsigned char*)cur[q].dst + (size_t)rn * cur[q].K + 8 * cc)); }
            else __builtin_nontemporal_store(w, (u32x4*)(cur[q].dst + (size_t)rn * cur[q].K + 8 * cc)); }
#pragma unroll
        for (int q = 0; q < NB; ++q) { cur[q] = nxt[q]; a[q] = na[q]; b[q] = nb[q]; }
        k0 = nk0; k1 = nk1;
        buf ^= 1;
    }
    { bf16_t* wbg = (bf16_t*)(p->ws + OFF_WBG);
      for (int i = c * NTHREADS + tid; i < 2 * 4 * 256 * 256 / 4; i += G * NTHREADS) {
          const int m4 = (i & 63) * 4, jg = i >> 14;
          const f32x4 w = *(const f32x4*)(p->in[10] + (size_t)i * 4), s = *(const f32x4*)(p->in[11] + jg * 256 + m4);
          u32x2 o; o.x = pk_bf16(w[0] * s[0], w[1] * s[1]); o.y = pk_bf16(w[2] * s[2], w[3] * s[3]);
          *(u32x2*)(wbg + (size_t)i * 4) = o; } }
    const int wid = __builtin_amdgcn_readfirstlane(tid >> 6), lane = tid & 63;
    bf16_t* XB0 = (bf16_t*)(p->ws + OFF_XB); float* rstd_arr = (float*)(p->ws + OFF_RSTD); const float* xin = p->in[0];
    const int nwaves = G * 8, rpw = (T_ + nwaves - 1) / nwaves;
    const int w0 = (c * 8 + wid) * rpw; int nr = T_ - w0; nr = nr > rpw ? rpw : nr;
    if (nr > 0) {
        float x[16], xn[16]; row_load_f32(xin + (size_t)w0 * 1024, lane, x);
        for (int r = 0; r < nr; ++r) {
            const int row = w0 + r;
            if (r + 1 < nr) row_load_f32(xin + (size_t)(row + 1) * 1024, lane, xn);
            row_store_bf16(XB0 + (size_t)row * 1024, lane, x);
            float ss = 0.f;
#pragma unroll
            for (int jj = 0; jj < 16; ++jj) ss += x[jj] * x[jj];
            ss = wave_sum(ss, lane);
            const float rstd = rsqrtf(ss * (1.0f / 1024.0f) + EPS);
            if (lane == 0) rstd_arr[row] = rstd;
#pragma unroll
            for (int jj = 0; jj < 16; ++jj) x[jj] = xn[jj];
        }
    }
}

constexpr int SP_WL = 0, SP_WPITCH = 272, SP_VL = 128 * SP_WPITCH, SP_VPITCH = 528, SP_RS = SP_VL + 128 * SP_VPITCH;
__device__ void phase_spatial(LAS unsigned char* lds, KP p, int j, int c, int G) {
    const int tid = tid_opaque(), wid = tid >> 6, lane = tid & 63, fr = lane & 15, fq = lane >> 4;
    const bf16_t* Z = (const bf16_t*)(p->ws + OFF_Z); bf16_t* YS = (bf16_t*)(p->ws + OFF_YS);
    const float* Ws = p->in[6] + (size_t)j * 8 * 128 * 128; const float* bs = p->in[7] + j * 8 * 128; const float* gv = p->in[5] + j * 2048; const float* vss = (const float*)(p->ws + OFF_VSS) + (size_t)j * T_ * 32;
    LAS float* RS = (LAS float*)(lds + SP_RS);
    const int dw = wid * 32;
    int wh = -1; u32x4 vreg[8]; f32x4 wreg[8]; f32x4 sreg[2];
    float bsr[8]; f32x4 g0, g1;
#pragma unroll
    for (int jt = 0; jt < 8; ++jt) bsr[jt] = 0.f;
    g0 = (f32x4){0.f, 0.f, 0.f, 0.f}; g1 = g0;
    u32x4 ureg[8];
    auto issue = [&](int unit) {
        const int h = unit & 7, bcn = unit >> 3, row0 = bcn * 128;
        { const f32x4* vp = (const f32x4*)(vss + (size_t)(row0 + (tid >> 2)) * 32 + (tid & 3) * 8); sreg[0] = vp[0]; sreg[1] = vp[1]; }
#pragma unroll
        for (int it = 0; it < 8; ++it) { const int r = it * 16 + (tid >> 5), ch = tid & 31; vreg[it] = __builtin_nontemporal_load((const u32x4*)(Z + ((size_t)(bcn * 16 + 8 + h) * 128 + r) * 256 + ch * 8)); }
        if (h != wh) { wh = h; const int t = tid >> 2, s0 = (tid & 3) * 32; const float* wp = Ws + ((size_t)h * 128 + t) * 128 + s0;
#pragma unroll
          for (int q = 0; q < 8; ++q) wreg[q] = *(const f32x4*)(wp + 4 * q);
#pragma unroll
          for (int jt = 0; jt < 8; ++jt) bsr[jt] = bs[h * 128 + 16 * jt + fr];
          g0 = *(const f32x4*)(gv + h * 256 + dw + 8 * fq); g1 = *(const f32x4*)(gv + h * 256 + dw + 8 * fq + 4); }
    };
    auto issue_u = [&](int unit, int hf) {
        const int h = unit & 7, bcn = unit >> 3;
#pragma unroll
        for (int jj = 0; jj < 4; ++jj) { const int jt = 4 * hf + jj; ureg[jt] = __builtin_nontemporal_load((const u32x4*)(Z + ((size_t)(bcn * 16 + h) * 128 + 16 * jt + fr) * 256 + dw + 8 * fq)); }
    };
    if (c < 2048) { issue(c); issue_u(c, 0); issue_u(c, 1); }
    for (int unit = c; unit < 2048; unit += G) {
        const int h = unit & 7, bc = unit >> 3, row0 = bc * 128;
        const int colb = h * 256 + dw + 8 * fq;
        { float s = ((sreg[0][0] + sreg[0][1]) + (sreg[0][2] + sreg[0][3])) + ((sreg[1][0] + sreg[1][1]) + (sreg[1][2] + sreg[1][3]));
          s += lperm((tid & 63) ^ 1, s); s += lperm((tid & 63) ^ 2, s);
          if ((tid & 3) == 0) RS[tid >> 2] = rsqrtf(s * (1.0f / 2048.0f) + EPS); }
#pragma unroll
        for (int it = 0; it < 8; ++it) { const int r = it * 16 + (tid >> 5), ch = tid & 31; *(LAS u32x4*)(lds + SP_VL + r * SP_VPITCH + ch * 16) = vreg[it]; }
        __syncthreads();
        { const int t = tid >> 2, s0 = (tid & 3) * 32;
#pragma unroll
          for (int q = 0; q < 4; ++q) { const f32x4 a = wreg[2 * q], b = wreg[2 * q + 1]; const int s = s0 + 8 * q;
              u32x4 w; w.x = pk_bf16(a[0] * RS[s], a[1] * RS[s + 1]); w.y = pk_bf16(a[2] * RS[s + 2], a[3] * RS[s + 3]); w.z = pk_bf16(b[0] * RS[s + 4], b[1] * RS[s + 5]); w.w = pk_bf16(b[2] * RS[s + 6], b[3] * RS[s + 7]);
              *(LAS u32x4*)(lds + SP_WL + t * SP_WPITCH + s * 2) = w; } }
        __syncthreads();
        if (unit + G < 2048) issue(unit + G);
        const int li = lane & 15, q = li >> 2, pp = li & 3;
        const LAS unsigned char* vbase = lds + SP_VL + (8 * fq + q) * SP_VPITCH + (dw + 8 * pp) * 2;
        const LAS unsigned char* wbase = lds + SP_WL + fr * SP_WPITCH + (8 * fq) * 2;
#pragma unroll
        for (int hf = 0; hf < 2; ++hf) {
            f32x4 acc[2][4];
#pragma unroll
            for (int n = 0; n < 2; ++n)
#pragma unroll
                for (int jj = 0; jj < 4; ++jj) acc[n][jj] = (f32x4){0.f, 0.f, 0.f, 0.f};
#pragma unroll
            for (int ks = 0; ks < 4; ++ks) {
                bf16x8 af[2];
#pragma unroll
                for (int n = 0; n < 2; ++n) {
                    const s16x4 lo = __builtin_bit_cast(s16x4, __builtin_amdgcn_ds_read_tr16_b64_v4i16((LAS s16x4*)(vbase + (32 * ks) * SP_VPITCH + 8 * n)));
                    const s16x4 hi = __builtin_bit_cast(s16x4, __builtin_amdgcn_ds_read_tr16_b64_v4i16((LAS s16x4*)(vbase + (32 * ks + 4) * SP_VPITCH + 8 * n)));
                    af[n] = (bf16x8){lo[0], lo[1], lo[2], lo[3], hi[0], hi[1], hi[2], hi[3]}; }
#pragma unroll
                for (int jj = 0; jj < 4; ++jj) { const bf16x8 bfr = *(const LAS bf16x8*)(wbase + (16 * (4 * hf + jj)) * SP_WPITCH + (32 * ks) * 2);
                    acc[0][jj] = __builtin_amdgcn_mfma_f32_16x16x32_bf16(af[0], bfr, acc[0][jj], 0, 0, 0);
                    acc[1][jj] = __builtin_amdgcn_mfma_f32_16x16x32_bf16(af[1], bfr, acc[1][jj], 0, 0, 0); }
            }
#pragma unroll
            for (int jj = 0; jj < 4; ++jj) { const int jt = 4 * hf + jj, t = 16 * jt + fr, row = row0 + t; const float bsv = bsr[jt];
                const u32x4 uw = ureg[jt];
                const f32x2 ua = gelu_pk((f32x2){bf_lo(uw.x), bf_hi(uw.x)}), ub = gelu_pk((f32x2){bf_lo(uw.y), bf_hi(uw.y)}), uc = gelu_pk((f32x2){bf_lo(uw.z), bf_hi(uw.z)}), ud = gelu_pk((f32x2){bf_lo(uw.w), bf_hi(uw.w)});
                const f32x4 s0 = acc[0][jj] * g0 + bsv, s1 = acc[1][jj] * g1 + bsv;
                u32x4 w; w.x = pk_bf16(ua.x * s0[0], ua.y * s0[1]); w.y = pk_bf16(ub.x * s0[2], ub.y * s0[3]);
                w.z = pk_bf16(uc.x * s1[0], uc.y * s1[1]); w.w = pk_bf16(ud.x * s1[2], ud.y * s1[3]);
                *(u32x4*)(YS + (size_t)row * 2048 + colb) = w; }
            if (unit + G < 2048) issue_u(unit + G, hf);
        }
        __syncthreads();
    }
}

template <int GRP>
__device__ __forceinline__ void pool_item(const bf16_t* V1, bf16_t* Dp, int row0, int ch) {
    constexpr int W = 2 << GRP, HW = W / 2, NR = 8 + W - 1;
    const int t0 = row0 & (SEQ - 1);
    const bf16_t* base = V1 + (size_t)(row0 - t0) * 1024 + ch * 8;
    u32x4 buf[NR];
#pragma unroll
    for (int jj = 0; jj < NR; ++jj) { const int t = t0 - HW + jj; buf[jj] = (t >= 0 && t < SEQ) ? *(const u32x4*)(base + (size_t)t * 1024) : (u32x4){0u, 0u, 0u, 0u}; }
    float s[8];
#pragma unroll
    for (int e = 0; e < 8; ++e) s[e] = 0.f;
#pragma unroll
    for (int jj = 0; jj < W - 1; ++jj) { const u32x4 v = buf[jj];
        s[0] += bf_lo(v.x); s[1] += bf_hi(v.x); s[2] += bf_lo(v.y); s[3] += bf_hi(v.y); s[4] += bf_lo(v.z); s[5] += bf_hi(v.z); s[6] += bf_lo(v.w); s[7] += bf_hi(v.w); }
#pragma unroll
    for (int i = 0; i < 8; ++i) {
        { const u32x4 v = buf[i + W - 1];
          s[0] += bf_lo(v.x); s[1] += bf_hi(v.x); s[2] += bf_lo(v.y); s[3] += bf_hi(v.y); s[4] += bf_lo(v.z); s[5] += bf_hi(v.z); s[6] += bf_lo(v.w); s[7] += bf_hi(v.w); }
        const int t = t0 + i; int lo = t - HW, hi = t + HW; lo = lo < 0 ? 0 : lo; hi = hi > SEQ ? SEQ : hi;
        const float inv = 1.0f / (float)(hi - lo);
        const u32x4 v = buf[i + HW];
        u32x4 o; o.x = pk_bf16(s[0] * inv - bf_lo(v.x), s[1] * inv - bf_hi(v.x)); o.y = pk_bf16(s[2] * inv - bf_lo(v.y), s[3] * inv - bf_hi(v.y));
        o.z = pk_bf16(s[4] * inv - bf_lo(v.z), s[5] * inv - bf_hi(v.z)); o.w = pk_bf16(s[6] * inv - bf_lo(v.w), s[7] * inv - bf_hi(v.w));
        *(u32x4*)(Dp + (size_t)(row0 + i) * 1024 + ch * 8) = o;
        { const u32x4 q = buf[i];
          s[0] -= bf_lo(q.x); s[1] -= bf_hi(q.x); s[2] -= bf_lo(q.y); s[3] -= bf_hi(q.y); s[4] -= bf_lo(q.z); s[5] -= bf_hi(q.z); s[6] -= bf_lo(q.w); s[7] -= bf_hi(q.w); }
    }
}
__device__ void phase_pool(KP p, int c, int G) {
    const bf16_t* V1 = (const bf16_t*)(p->ws + OFF_Z); bf16_t* Dp = (bf16_t*)(p->ws + OFF_Z) + (size_t)T_ * 1024;
    const int tid = tid_opaque(), wid = __builtin_amdgcn_readfirstlane(tid >> 6), lane = tid & 63;
    for (int wi = c * 8 + wid; wi < (T_ / 16) * 4; wi += G * 8) {
        const int g = wi & 3, rp = wi >> 2;
        const int row0 = rp * 16 + (lane >> 5) * 8, ch = g * 32 + (lane & 31);
        switch (g) {
        case 0: pool_item<0>(V1, Dp, row0, ch); break;
        case 1: pool_item<1>(V1, Dp, row0, ch); break;
        case 2: pool_item<2>(V1, Dp, row0, ch); break;
        default: pool_item<3>(V1, Dp, row0, ch); break;
        }
    }
}

constexpr int RW_PITCH = 1032;
constexpr int RW_BYTES = 36 * RW_PITCH * 2;
__device__ void phase_router(LAS unsigned char* lds, KP p, int layer, int c, int G, int cset) {
    const int tid = tid_opaque(), wid = __builtin_amdgcn_readfirstlane(tid >> 6), lane = tid & 63, fr = lane & 15, fq = lane >> 4;
    LAS bf16_t* WH = (LAS bf16_t*)lds; LAS bf16_t* WL = (LAS bf16_t*)(lds + RW_BYTES);
    const float* rgw = p->in[13] + (size_t)layer * 1024 * 4; const float* rgb = p->in[14] + layer * 4;
    const float* rew = p->in[15] + (size_t)layer * 1024 * 32; const float* reb = p->in[16] + layer * 32;
    const float* xss = (const float*)(p->ws + OFF_XSS);
    u32x4 xa[16], xb[16]; f32x4 ppx = (f32x4){0.f, 0.f, 0.f, 0.f};
    const bool act0 = c * 8 + wid < T_ / 16;
    const bf16_t* xr0 = (const bf16_t*)(p->ws + OFF_XB) + (size_t)((act0 ? c * 8 + wid : 0) * 16 + fr) * 1024 + 8 * fq;
    if (act0) { ppx = *(const f32x4*)(xss + (size_t)((c * 8 + wid) * 16 + fr) * 16 + 4 * fq);
#pragma unroll
        for (int ks = 0; ks < 16; ++ks) xa[ks] = *(const u32x4*)(xr0 + 32 * ks); }
    else {
#pragma unroll
        for (int ks = 0; ks < 16; ++ks) xa[ks] = (u32x4){0u, 0u, 0u, 0u}; }
    const float* gf = p->in[2] + layer * 1024;
#pragma unroll 1
    for (int k = tid; k < 1024; k += NTHREADS) {
        const float gk = gf[k];
        const f32x4 a = *(const f32x4*)(rgw + k * 4) * gk;
#pragma unroll
        for (int jj = 0; jj < 4; ++jj) { const unsigned hi = pk_bf16(a[jj], 0.f) & 0xffffu; const float rem = a[jj] - __uint_as_float(hi << 16);
            WH[jj * RW_PITCH + k] = (bf16_t)hi; WL[jj * RW_PITCH + k] = (bf16_t)(pk_bf16(rem, 0.f) & 0xffffu); }
#pragma unroll
        for (int q = 0; q < 8; ++q) { const f32x4 b = *(const f32x4*)(rew + k * 32 + 4 * q) * gk;
#pragma unroll
            for (int jj = 0; jj < 4; ++jj) { const unsigned hi = pk_bf16(b[jj], 0.f) & 0xffffu; const float rem = b[jj] - __uint_as_float(hi << 16);
                WH[(4 + 4 * q + jj) * RW_PITCH + k] = (bf16_t)hi; WL[(4 + 4 * q + jj) * RW_PITCH + k] = (bf16_t)(pk_bf16(rem, 0.f) & 0xffffu); } }
    }
    LAS float* lbias = (LAS float*)(lds + LDS_MISC + 512);
    if (tid < 36) lbias[tid] = tid < 4 ? rgb[tid] : reb[tid - 4];
    __builtin_amdgcn_sched_barrier(0);
    if (act0) {
#pragma unroll
        for (int ks = 0; ks < 16; ++ks) xb[ks] = *(const u32x4*)(xr0 + 32 * (16 + ks)); }
    else {
#pragma unroll
        for (int ks = 0; ks < 16; ++ks) xb[ks] = (u32x4){0u, 0u, 0u, 0u}; }
    __syncthreads();
    float* rss = (float*)(p->ws + OFF_RSS);
    unsigned* cnt = (unsigned*)(p->ws + OFF_CTL) + CW_CNT + cset * 32 * 16;
    int* list = (int*)(p->ws + OFF_LIST); i32x4* slot = (i32x4*)(p->ws + OFF_SLOT); f32x2* gates = (f32x2*)(p->ws + OFF_GATE);
    LAS unsigned* lcnt = (LAS unsigned*)(lds + LDS_MISC + 64); LAS unsigned* lbase = lcnt + 32;
    int wrow[3];
#pragma unroll
    for (int t = 0; t < 3; ++t) { const int o = 16 * t + fr; wrow[t] = (o < 36 ? o : 35) * RW_PITCH + 8 * fq; }
    for (int cb = c * 8; cb < T_ / 16; cb += G * 8) {
        const int ch = cb + wid; const bool active = ch < T_ / 16;
        if (tid < 32) lcnt[tid] = 0u;
        __syncthreads();
        const int row = (active ? ch : 0) * 16 + fr;
        int e0 = 0, e1 = 0, k0 = 0, k1 = 0; float gt0 = 0.f, gt1 = 0.f, rstd_row = 0.f;
        if (active) {
            if (cb != c * 8) { const bf16_t* xr = (const bf16_t*)(p->ws + OFF_XB) + (size_t)row * 1024 + 8 * fq;
                ppx = *(const f32x4*)(xss + (size_t)row * 16 + 4 * fq);
#pragma unroll
                for (int ks = 0; ks < 16; ++ks) { xa[ks] = *(const u32x4*)(xr + 32 * ks); xb[ks] = *(const u32x4*)(xr + 32 * (16 + ks)); } }
            float ss = (ppx[0] + ppx[1]) + (ppx[2] + ppx[3]);
            ss += lperm(lane ^ 16, ss); ss += lperm(lane ^ 32, ss);
            const float rstd = rsqrtf(ss * (1.0f / 1024.0f) + EPS); rstd_row = rstd;
            if ((F8_LAYERS >> layer) & 1) {
                unsigned char* xq = p->ws + OFF_H + (size_t)row * 1024 + 8 * fq; const float sc = rstd * F8_XSC;
#pragma unroll
                for (int ks = 0; ks < 32; ++ks) { const u32x4 xw = ks < 16 ? xa[ks & 15] : xb[ks & 15];
                    u32x2 b8; b8.x = pk_fp8x4(bf_lo(xw.x) * sc, bf_hi(xw.x) * sc, bf_lo(xw.y) * sc, bf_hi(xw.y) * sc); b8.y = pk_fp8x4(bf_lo(xw.z) * sc, bf_hi(xw.z) * sc, bf_lo(xw.w) * sc, bf_hi(xw.w) * sc);
                    *(u32x2*)(xq + 32 * ks) = b8; } }
            f32x4 acc[3];
            const LAS bf16_t* whp[3]; const LAS bf16_t* wlp[3];
#pragma unroll
            for (int t = 0; t < 3; ++t) { acc[t] = (f32x4){0.f, 0.f, 0.f, 0.f}; whp[t] = WH + wrow[t]; wlp[t] = WL + wrow[t]; asm volatile("" : "+v"(whp[t]), "+v"(wlp[t])); }
#pragma unroll
            for (int ks = 0; ks < 32; ++ks) {
                const bf16x8 fh = __builtin_bit_cast(bf16x8, ks < 16 ? xa[ks & 15] : xb[ks & 15]);
#pragma unroll
                for (int t = 0; t < 3; ++t) { const bf16x8 wh = *(const LAS bf16x8*)(whp[t] + 32 * ks), wl = *(const LAS bf16x8*)(wlp[t] + 32 * ks);
                    acc[t] = __builtin_amdgcn_mfma_f32_16x16x32_bf16(wh, fh, acc[t], 0, 0, 0);
                    acc[t] = __builtin_amdgcn_mfma_f32_16x16x32_bf16(wl, fh, acc[t], 0, 0, 0); }
            }
#pragma unroll
            for (int t = 0; t < 3; ++t) acc[t] = acc[t] * rstd;
            f32x4 lg[3];
#pragma unroll
            for (int t = 0; t < 3; ++t)
#pragma unroll
                for (int r = 0; r < 4; ++r) { const int o = 16 * t + 4 * fq + r; const float b = lbias[o < 36 ? o : 35]; lg[t][r] = acc[t][r] + b; }
            float gl[4];
#pragma unroll
            for (int jj = 0; jj < 4; ++jj) gl[jj] = lperm(fr, lg[0][jj]);
            int gi = 0; float gm = gl[0];
#pragma unroll
            for (int jj = 1; jj < 4; ++jj) if (gl[jj] > gm) { gm = gl[jj]; gi = jj; }
            float gs = 0.f;
#pragma unroll
            for (int jj = 0; jj < 4; ++jj) gs += __expf(gl[jj] - gm);
            const float gw = 1.0f / gs;
            const int q1 = 1 + 2 * gi, q2 = 2 + 2 * gi, t1 = q1 >> 2, t2 = q2 >> 2;
            float el[8];
#pragma unroll
            for (int r = 0; r < 4; ++r) { const float c1 = t1 == 0 ? lg[0][r] : lg[1][r]; const float c2 = t2 == 0 ? lg[0][r] : t2 == 1 ? lg[1][r] : lg[2][r];
                el[r] = lperm(fr + 16 * (q1 & 3), c1); el[4 + r] = lperm(fr + 16 * (q2 & 3), c2); }
            int i0 = 0; float m0 = el[0];
#pragma unroll
            for (int jj = 1; jj < 8; ++jj) if (el[jj] > m0) { m0 = el[jj]; i0 = jj; }
            int i1 = -1; float m1 = -INFINITY;
#pragma unroll
            for (int jj = 0; jj < 8; ++jj) if (jj != i0 && el[jj] > m1) { m1 = el[jj]; i1 = jj; }
            const float ex = __expf(m1 - m0), w0 = 1.0f / (1.0f + ex), w1 = ex * w0;
            e0 = gi * 8 + i0; e1 = gi * 8 + i1; gt0 = gw * w0; gt1 = gw * w1;
            if (fq == 0) { k0 = (int)__hip_atomic_fetch_add(lcnt + e0, 1u, __ATOMIC_RELAXED, __HIP_MEMORY_SCOPE_WORKGROUP); k1 = (int)__hip_atomic_fetch_add(lcnt + e1, 1u, __ATOMIC_RELAXED, __HIP_MEMORY_SCOPE_WORKGROUP); }
        }
        __syncthreads();
        if (tid < 32) { const unsigned n = lcnt[tid]; lbase[tid] = n ? atomicAdd(cnt + tid * 16, n) : 0u; }
        __syncthreads();
        if (active && fq == 0) {
            const int p0 = (int)lbase[e0] + k0, p1 = (int)lbase[e1] + k1;
            list[e0 * LIST_CAP + p0] = row; list[e1 * LIST_CAP + p1] = row; rss[e0 * LIST_CAP + p0] = rstd_row; rss[e1 * LIST_CAP + p1] = rstd_row;
            slot[row] = (i32x4){e0, p0, e1, p1}; gates[row] = (f32x2){gt0, gt1};
        }
    }
}

struct CombRow { u32x4 x[2]; u32x4 y0[2], y1[2]; };
__device__ __forceinline__ void comb_load(CombRow& r, const bf16_t* xrow, const bf16_t* y0, const bf16_t* y1, int lane) {
#pragma unroll
    for (int k = 0; k < 2; ++k) { r.x[k] = *(const u32x4*)(xrow + 512 * k + 8 * lane);
        r.y0[k] = __builtin_nontemporal_load((const u32x4*)(y0 + 512 * k + 8 * lane)); r.y1[k] = __builtin_nontemporal_load((const u32x4*)(y1 + 512 * k + 8 * lane)); }
}
__device__ void phase_combine(KP p, int layer, int c, int G, float* Xout) {
    const int tid = tid_opaque(), wid = __builtin_amdgcn_readfirstlane(tid >> 6), lane = tid & 63;
    const unsigned* cnt = (const unsigned*)(p->ws + OFF_CTL) + CW_CNT + layer * 32 * 16;
    int tb;
    { int cn = 0; if (lane < 32) cn = (int)__hip_atomic_load(cnt + lane * 16, __ATOMIC_RELAXED, __HIP_MEMORY_SCOPE_AGENT);
      const int tl = (cn + 255) >> 8; int v = tl;
#pragma unroll
      for (int d = 1; d < 32; d <<= 1) { const int t = lperm(lane - d, v); if (lane >= d) v += t; }
      tb = v - tl; }
    const bf16_t* YM = (const bf16_t*)(p->ws + OFF_Z + HID_BYTES);
    const i32x4* slot = (const i32x4*)(p->ws + OFF_SLOT); const f32x2* gates = (const f32x2*)(p->ws + OFF_GATE);
    bf16_t* X = (bf16_t*)(p->ws + OFF_XB); float* rstd_arr = (float*)(p->ws + OFF_RSTD);
    const bool last = layer == 3; const float* gn = last ? p->in[20] : p->in[1] + (layer + 1) * 1024;
    float gv[16]; row_load_f32(gn, lane, gv);
    const int nwaves = G * 8, rpw = (T_ + nwaves - 1) / nwaves;
    const int w0 = (c * 8 + wid) * rpw; int nr = T_ - w0; nr = nr > rpw ? rpw : nr;
    if (nr <= 0) return;
    int r0v = 0, r1v = 0; float g0v = 0.f, g1v = 0.f;
    { i32x4 sm = (i32x4){0, 0, 0, 0}; f32x2 gm = (f32x2){0.f, 0.f};
      if (lane < nr) { sm = slot[w0 + lane]; gm = gates[w0 + lane]; }
      r0v = lperm(sm[0], tb) * 256 + sm[1]; r1v = lperm(sm[2], tb) * 256 + sm[3]; g0v = gm.x; g1v = gm.y; }
    CombRow cur, nxt;
    comb_load(cur, X + (size_t)w0 * 1024, YM + (size_t)__builtin_amdgcn_readlane(r0v, 0) * 1024, YM + (size_t)__builtin_amdgcn_readlane(r1v, 0) * 1024, lane);
    for (int r = 0; r < nr; ++r) {
        const int row = w0 + r;
        if (r + 1 < nr) comb_load(nxt, X + (size_t)(row + 1) * 1024, YM + (size_t)__builtin_amdgcn_readlane(r0v, r + 1) * 1024, YM + (size_t)__builtin_amdgcn_readlane(r1v, r + 1) * 1024, lane);
        const float g0 = __builtin_bit_cast(float, __builtin_amdgcn_readlane(__builtin_bit_cast(int, g0v), r)), g1 = __builtin_bit_cast(float, __builtin_amdgcn_readlane(__builtin_bit_cast(int, g1v), r));
        float x[16];
#pragma unroll
        for (int k = 0; k < 2; ++k) { const u32x4 a = cur.y0[k], b = cur.y1[k], xv = cur.x[k];
            x[8 * k + 0] = bf_lo(xv.x) + g0 * bf_lo(a.x) + g1 * bf_lo(b.x); x[8 * k + 1] = bf_hi(xv.x) + g0 * bf_hi(a.x) + g1 * bf_hi(b.x);
            x[8 * k + 2] = bf_lo(xv.y) + g0 * bf_lo(a.y) + g1 * bf_lo(b.y); x[8 * k + 3] = bf_hi(xv.y) + g0 * bf_hi(a.y) + g1 * bf_hi(b.y);
            x[8 * k + 4] = bf_lo(xv.z) + g0 * bf_lo(a.z) + g1 * bf_lo(b.z); x[8 * k + 5] = bf_hi(xv.z) + g0 * bf_hi(a.z) + g1 * bf_hi(b.z);
            x[8 * k + 6] = bf_lo(xv.w) + g0 * bf_lo(a.w) + g1 * bf_lo(b.w); x[8 * k + 7] = bf_hi(xv.w) + g0 * bf_hi(a.w) + g1 * bf_hi(b.w); }
        float ss = 0.f;
#pragma unroll
        for (int jj = 0; jj < 16; ++jj) ss += x[jj] * x[jj];
        ss = wave_sum(ss, lane);
        const float rstd = rsqrtf(ss * (1.0f / 1024.0f) + EPS);
        if (last) { float o[16];
#pragma unroll
            for (int jj = 0; jj < 16; ++jj) o[jj] = x[jj] * rstd * gv[jj];
            row_store_f32(Xout + (size_t)row * 1024, lane, o); }
        else { row_store_bf16(X + (size_t)row * 1024, lane, x); if (lane == 0) rstd_arr[row] = rstd; }
        cur = nxt;
    }
}

enum { K_PREP = 0, K_A1, K_A2, K_A3, K_B1, K_B2, K_B3, K_B4, K_M1, K_M2, K_M3, K_M4 };
constexpr int NPHASES = 29;
__device__ __forceinline__ void phase_decode(int ph, int& kind, int& layer) {
    if (ph == 0) { kind = K_PREP; layer = 0; return; }
    const int q = ph - 1, pair = q / 14, off = q % 14;
    if (off < 7) { layer = 2 * pair; kind = off < 3 ? K_A1 + off : K_M1 + (off - 3); }
    else { layer = 2 * pair + 1; const int o = off - 7; kind = o == 0 ? K_B1 : o == 1 ? K_B2 : o == 2 ? K_B4 : K_M1 + (o - 3); }
}

__global__ void __launch_bounds__(NTHREADS, 2) mk(Params p_arg, int ph_lo, int ph_hi, int coop) {
    extern __shared__ __attribute__((aligned(16))) unsigned char smem[];
    LAS unsigned char* lds = (LAS unsigned char*)smem;
    volatile LAS unsigned* st = (volatile LAS unsigned*)(lds + LDS_MISC);
    { const int t0 = (int)threadIdx.x; *(volatile LAS int*)(lds + LDS_WVTAB + hw_slot() * 4) = t0 >> 6; if (t0 < 4) st[t0] = 0u; }
    __syncthreads();
    XcdBarrier bar; bar.bar = (unsigned*)(p_arg.ws + OFF_CTL); bar.x = 0; bar.st = st;
    if (ph_hi - ph_lo > 1) bar = xcd_barrier_post((unsigned*)(p_arg.ws + OFF_CTL), st);
#ifdef REP_KIND
    int rep_done = 0;
#endif
    for (int ph = ph_lo; ph < ph_hi; ++ph) {
        int kind, layer; phase_decode(ph, kind, layer);
        KP p = (KP)__builtin_amdgcn_kernarg_segment_ptr();
        int c = blockIdx.x, G = gridDim.x;
        asm volatile("" : "+s"(kind), "+s"(layer), "+s"(p), "+s"(c), "+s"(G));
        unsigned char* ws = p->ws;
        const int j = layer >> 1;
        switch (kind) {
        case K_PREP: phase_prep(lds, p, c, G); break;
        case K_A1: { GemmDesc g{(const bf16_t*)(ws + OFF_XB), (const bf16_t*)(ws + OFF_WAIN) + (size_t)j * 4096 * 1024, 1024, 1024, 1024, nullptr};
            DenseSched S; S.init(T_, 4096, G, c, 1024, 1024, 0);
            EpiAin E{(bf16_t*)(ws + OFF_Z), p->in[4] + j * 4096, (float*)(ws + OFF_VSS) + (size_t)j * T_ * 32, (const float*)(ws + OFF_RSTD)};
            gemm_phase<EpiAin, DenseSched, false>(lds, g, S, E);
            } break;
        case K_A2: phase_spatial(lds, p, j, c, G); break;
        case K_A3: { GemmDesc g{(const bf16_t*)(ws + OFF_YS), (const bf16_t*)(ws + OFF_WAOUT) + (size_t)j * 1024 * 2048, 2048, 2048, 2048, nullptr};
            DenseSched S; S.init(T_, 1024, G, c, 2048, 2048, 0);
            EpiResid E{(bf16_t*)(ws + OFF_XB), (float*)(ws + OFF_XSS)};
            gemm_phase<EpiResid, DenseSched, false>(lds, g, S, E); } break;
        case K_B1: { GemmDesc g{(const bf16_t*)(ws + OFF_XB), (const bf16_t*)(ws + OFF_WBIN) + (size_t)j * 1024 * 1024, 1024, 1024, 1024, nullptr};
            DenseSched S; S.init(T_, 1024, G, c, 1024, 1024, 0);
            EpiBf E{(bf16_t*)(ws + OFF_Z), 1024, nullptr, (const float*)(ws + OFF_RSTD)};
            gemm_phase<EpiBf, DenseSched, false>(lds, g, S, E); } break;
        case K_B2: phase_pool(p, c, G); break;
        case K_B4: { GemmDesc g{(const bf16_t*)(ws + OFF_Z) + (size_t)T_ * 1024, (const bf16_t*)(ws + OFF_WBOUT) + (size_t)j * 1024 * 1024, 1024, 1024, 1024, nullptr};
            DenseSched S; S.init(T_, 1024, G, c, 1024, 1024, 0);
            EpiResid E{(bf16_t*)(ws + OFF_XB), (float*)(ws + OFF_XSS)};
            gemm_phase<EpiResid, DenseSched, false>(lds, g, S, E); } break;
        case K_M1:
#ifdef PROBE_M1
            phase_router(lds, p, layer, c, G, layer + 4); xcd_barrier(bar);
#endif
            phase_router(lds, p, layer, c, G, layer); break;
        case K_M2: if ((F8_LAYERS >> layer) & 1) {
            GemmDesc g{(const bf16_t*)(ws + OFF_H), (const bf16_t*)(ws + OFF_WGU) + (size_t)layer * 32 * 1024 * 1024, 512, 512, 512, (const int*)(ws + OFF_LIST)};
            MoeSched S; S.init((const unsigned*)(ws + OFF_CTL) + CW_CNT + layer * 32 * 16, G, c, 0, 1);
            EpiSwiglu8 E{ws + OFF_Z, 1.0f / (F8_XSC * F8_WSC)};
            gemm_phase<EpiSwiglu8, MoeSched, true, true>(lds, g, S, E); }
          else { GemmDesc g{(const bf16_t*)(ws + OFF_XB), (const bf16_t*)(ws + OFF_WGU) + (size_t)layer * 32 * 1024 * 1024, 1024, 1024, 1024, (const int*)(ws + OFF_LIST)};
            MoeSched S; S.init((const unsigned*)(ws + OFF_CTL) + CW_CNT + layer * 32 * 16, G, c, 0);
            EpiSwiglu E{(bf16_t*)(ws + OFF_Z), (const float*)(ws + OFF_RSS)};
            gemm_phase<EpiSwiglu, MoeSched, true>(lds, g, S, E); }
            if (layer == 0) {
                const int fb = G > 32 ? G - 32 : 0;
                if (c >= fb) {
                    int kf = 256; asm volatile("" : "+s"(kf));
                    GemmDesc gf{(const bf16_t*)(ws + OFF_WBT), (const bf16_t*)(ws + OFF_WBG), 1024, 256, kf, nullptr};
                    FoldSched SF{G - fb, c - fb}; EpiBf EF{(bf16_t*)(ws + OFF_WBOUT), 1024, nullptr, nullptr};
                    gemm_phase<EpiBf, FoldSched, false>(lds, gf, SF, EF); } }
            break;
        case K_M3: if ((F8_LAYERS >> layer) & 1) {
            GemmDesc g{(const bf16_t*)(ws + OFF_Z), (const bf16_t*)(ws + OFF_WDN) + (size_t)layer * 32 * 1024 * 512, 256, 256, 256, nullptr};
            MoeSched S; S.init((const unsigned*)(ws + OFF_CTL) + CW_CNT + layer * 32 * 16, G, c, 1, 1);
            EpiY8 E{(bf16_t*)(ws + OFF_Z + HID_BYTES), 1.0f / (F8_HSC * F8_WSC)};
            gemm_phase<EpiY8, MoeSched, false, true>(lds, g, S, E); }
          else { GemmDesc g{(const bf16_t*)(ws + OFF_Z), (const bf16_t*)(ws + OFF_WDN) + (size_t)layer * 32 * 1024 * 512, 512, 512, 512, nullptr};
            MoeSched S; S.init((const unsigned*)(ws + OFF_CTL) + CW_CNT + layer * 32 * 16, G, c, 1);
            EpiBf E{(bf16_t*)(ws + OFF_Z + HID_BYTES), 1024, nullptr, nullptr};
            gemm_phase<EpiBf, MoeSched, false>(lds, g, S, E); } break;
        case K_M4:
#ifdef PROBE_M4
            phase_combine(p, layer == 3 ? 2 : layer, c, G, (float*)(ws + OFF_YS)); xcd_barrier(bar);
#endif
            phase_combine(p, layer, c, G, p->X); break;
        }
#ifdef REP_KIND
        if (kind == REP_KIND && rep_done < REP_N - 1) { ++rep_done; xcd_barrier(bar); --ph; continue; }
        rep_done = 0;
#endif
        if (ph + 1 < ph_hi) {
#if MK_CG_SYNC
            if (coop && ph == ph_lo) { cg::this_grid().sync(); } else
#endif
            xcd_barrier(bar);
        }
    }
}

extern "C" void kernel_launch(void* const* d_in, const int* in_sizes, int n_in, void* d_out, int out_size, void* d_ws, size_t ws_size, hipStream_t stream) {
    static int grid = 0;
    if (!grid) {
        if (n_in != 21 || out_size != T_ * DM || ws_size < WS_END) { fprintf(stderr, "kernel_launch: unexpected shapes (n_in %d out %d ws %zu need %zu)\n", n_in, out_size, ws_size, (size_t)WS_END); return; }
        int dev = 0, cus = 0, per_cu = 0;
        hipGetDevice(&dev); hipDeviceGetAttribute(&cus, hipDeviceAttributeMultiprocessorCount, dev);
        if (hipFuncSetAttribute((const void*)mk, hipFuncAttributeMaxDynamicSharedMemorySize, LDS_BYTES) != hipSuccess) { fprintf(stderr, "kernel_launch: hipFuncSetAttribute failed\n"); return; }
        hipOccupancyMaxActiveBlocksPerMultiprocessor(&per_cu, (const void*)mk, NTHREADS, LDS_BYTES);
        if (per_cu < 1) { fprintf(stderr, "kernel_launch: occupancy query says %d blocks per CU\n", per_cu); per_cu = 1; }
        grid = cus * 1;
        if (grid % 8) grid -= grid % 8;
    }
    hipMemsetAsync((char*)d_ws + OFF_CTL, 0, CTL_BYTES, stream);
    Params p; memset(&p, 0, sizeof(p));
    for (int i = 0; i < 21; ++i) p.in[i] = (const float*)d_in[i];
    p.X = (float*)d_out; p.ws = (unsigned char*)d_ws;
#if MK_SINGLE
    int lo = 0, hi = NPHASES, coop = 1;
    void* args[] = {&p, &lo, &hi, &coop};
    hipError_t e = hipLaunchCooperativeKernel((const void*)mk, dim3(grid), dim3(NTHREADS), args, LDS_BYTES, stream);
    if (e != hipSuccess) fprintf(stderr, "cooperative launch failed: %s (grid %d)\n", hipGetErrorString(e), grid);
#else
    for (int ph = 0; ph < NPHASES; ++ph) hipLaunchKernelGGL(mk, dim3(grid), dim3(NTHREADS), LDS_BYTES, stream, p, ph, ph + 1, 0);
#endif
}
```

```cpp
#include <hip/hip_runtime.h>
#include <hip/hip_cooperative_groups.h>
#include <cstdio>
#include <cstdint>
#include <cstring>
namespace cg = cooperative_groups;

#ifndef MK_SINGLE
#define MK_SINGLE 1
#endif

#ifndef MK_CG_SYNC
#define MK_CG_SYNC 0
#endif

#define LAS __attribute__((address_space(3)))
typedef unsigned short bf16_t;
typedef short bf16x8 __attribute__((ext_vector_type(8)));
typedef short s16x4 __attribute__((ext_vector_type(4)));
typedef float f32x4 __attribute__((ext_vector_type(4)));
typedef float f32x2 __attribute__((ext_vector_type(2)));
typedef unsigned u32x4 __attribute__((ext_vector_type(4)));
typedef unsigned u32x2 __attribute__((ext_vector_type(2)));
typedef int i32x4 __attribute__((ext_vector_type(4)));
typedef __bf16 bf16x2_t __attribute__((ext_vector_type(2)));

constexpr int T_ = 32768, DM = 1024, SEQ = 2048;
constexpr int NTHREADS = 512;
constexpr float EPS = 1e-6f;
constexpr int LIST_CAP = 32768;
constexpr int MAX_TILES = 288;

constexpr size_t CTL_BYTES = 65536;
constexpr size_t OFF_CTL = 0;
constexpr size_t OFF_VSS = OFF_CTL + CTL_BYTES;
constexpr size_t OFF_XSS = OFF_VSS + (size_t)2 * T_ * 32 * 4;
constexpr size_t OFF_LIST = OFF_XSS + (size_t)T_ * 16 * 4;
constexpr size_t OFF_SLOT = OFF_LIST + (size_t)32 * LIST_CAP * 4;
constexpr size_t OFF_GATE = OFF_SLOT + (size_t)T_ * 16;
constexpr size_t OFF_WAIN = OFF_GATE + (size_t)T_ * 8;
constexpr size_t OFF_WAOUT = OFF_WAIN + (size_t)2 * 4096 * 1024 * 2;
constexpr size_t OFF_WBIN = OFF_WAOUT + (size_t)2 * 1024 * 2048 * 2;
constexpr size_t OFF_WBG = OFF_WBIN + (size_t)2 * 1024 * 1024 * 2;
constexpr size_t OFF_WBOUT = OFF_WBG + (size_t)2 * 4 * 256 * 256 * 2;
constexpr size_t OFF_WBT = OFF_WBOUT + (size_t)2 * 1024 * 1024 * 2;
constexpr size_t OFF_WGU = OFF_WBT + (size_t)2 * 1024 * 1024 * 2;
constexpr size_t OFF_WDN = OFF_WGU + (size_t)128 * 1024 * 1024 * 2;
constexpr size_t OFF_H = OFF_WDN + (size_t)128 * 1024 * 512 * 2;
constexpr size_t OFF_Z = OFF_H + (size_t)T_ * 1024 * 2;
constexpr size_t OFF_YS = OFF_Z + (size_t)T_ * 4096 * 2;
constexpr size_t OFF_XB = OFF_YS + (size_t)T_ * 2048 * 2;
constexpr size_t OFF_RSTD = OFF_XB + (size_t)T_ * 1024 * 2;
constexpr size_t OFF_RSS = OFF_RSTD + (size_t)T_ * 4;
constexpr size_t WS_END = OFF_RSS + (size_t)32 * LIST_CAP * 4;
constexpr size_t HID_BYTES = (size_t)MAX_TILES * 256 * 512 * 2;
constexpr int CW_CNT = 4096;

constexpr int STAGE_BYTES = 131072;
constexpr int LDS_MISC = 148608;
constexpr int LDS_BYTES = 148608 + 1024;

struct Params {
    const float* in[21];
    float* X;
    unsigned char* ws;
};
typedef const __attribute__((address_space(4))) Params* KP;

#ifndef F8_LAYERS
#define F8_LAYERS 0xF
#endif
#ifndef F8_Y
#define F8_Y 1
#endif
static_assert(!F8_Y || F8_LAYERS == 0xF, "F8_Y needs the fp8 expert path on every layer");
constexpr float F8_OSC = 16.f;
constexpr float F8_WSC = 64.f, F8_XSC = 4.f, F8_HSC = 4.f;
__device__ __forceinline__ unsigned pk_bf16(float lo, float hi) { f32x2 v = {lo, hi}; bf16x2_t b = __builtin_convertvector(v, bf16x2_t); return __builtin_bit_cast(unsigned, b); }
__device__ __forceinline__ unsigned pk_fp8x4(float a, float b, float c, float d) {
    a = __builtin_amdgcn_fmed3f(a, -448.f, 448.f); b = __builtin_amdgcn_fmed3f(b, -448.f, 448.f); c = __builtin_amdgcn_fmed3f(c, -448.f, 448.f); d = __builtin_amdgcn_fmed3f(d, -448.f, 448.f);
    int v = 0; v = __builtin_amdgcn_cvt_pk_fp8_f32(a, b, v, false); v = __builtin_amdgcn_cvt_pk_fp8_f32(c, d, v, true); return (unsigned)v; }
__device__ __forceinline__ float bf_lo(unsigned w) { return __uint_as_float(w << 16); }
__device__ __forceinline__ float bf_hi(unsigned w) { return __uint_as_float(w & 0xffff0000u); }
__device__ __forceinline__ int   lperm(int src, int v)   { return __builtin_amdgcn_ds_bpermute(src << 2, v); }
__device__ __forceinline__ float lperm(int src, float v) { return __int_as_float(__builtin_amdgcn_ds_bpermute(src << 2, __float_as_int(v))); }
__device__ __forceinline__ float wave_sum(float v, int lane) {
#pragma unroll
    for (int o = 32; o >= 1; o >>= 1) v += lperm(lane ^ o, v);
    return v;
}
__device__ __forceinline__ f32x2 gelu_pk(f32x2 v) {
    f32x2 c; c.x = __builtin_amdgcn_fmed3f(v.x, -4.5f, 4.5f); c.y = __builtin_amdgcn_fmed3f(v.y, -4.5f, 4.5f);
    const f32x2 s = c * c;
    f32x2 q = s * (-1.314259884e-12f) + 1.615359483e-10f;
    q = q * s + (-8.862621216e-09f); q = q * s + 2.885190317e-07f; q = q * s + (-6.266685043e-06f); q = q * s + 9.706125547e-05f;
    q = q * s + (-1.118662168e-03f); q = q * s + 9.821903153e-03f; q = q * s + (-6.632139887e-02f); q = q * s + 3.988761390e-01f;
    const f32x2 ph = c * q + 0.5f;
    return v * ph;
}
__device__ __forceinline__ float silu_f(float x) { return x * __builtin_amdgcn_rcpf(1.0f + __expf(-x)); }

extern __shared__ __attribute__((aligned(16))) unsigned char smem_tid[];
constexpr int LDS_WVTAB = LDS_MISC + 768;
__device__ __forceinline__ int hw_slot() { return (int)(__builtin_amdgcn_s_getreg((5 << 11) | 4) & 63u); }
__device__ __forceinline__ int tid_opaque() {
    int z = 0; asm volatile("" : "+v"(z));
    const int lane = (int)__builtin_amdgcn_mbcnt_hi(~0u, __builtin_amdgcn_mbcnt_lo(~0u, (unsigned)z));
    const int wv = __builtin_amdgcn_readfirstlane(*(volatile LAS int*)((LAS unsigned char*)smem_tid + LDS_WVTAB + hw_slot() * 4));
    int t = (wv << 6) | lane; asm volatile("" : "+v"(t)); return t; }

__device__ __forceinline__ size_t zoff(int row, int col) { return ((size_t)((row >> 7) * 16 + (col >> 8)) * 128 + (row & 127)) * 256 + (col & 255); }

constexpr int BM = 256, BK = 64, HALF = 128, HTB = HALF * BK * 2, NXCD = 8, WGM = 8;

__device__ __forceinline__ int lds_byte(int r, int c) { const int st = (r >> 4) * 2 + (c >> 5), rr = r & 15, cc = c & 31, ob = rr * 64 + cc * 2; return st * 1024 + (ob ^ (((ob >> 9) & 1) << 5)); }
__device__ __forceinline__ void stage_rc(int b, int& R, int& C) { const int st = b / 1024, sb = b % 1024, swz = sb ^ (((sb >> 9) & 1) << 5); R = (st >> 1) * 16 + swz / 64; C = (st & 1) * 32 + (swz % 64) / 2; }
__device__ __forceinline__ int perm32(int rho) { const int n = rho >> 4, i = rho & 15; return 8 * (i >> 2) + 4 * n + (i & 3); }

struct Unit { int orow, ocol; unsigned aoff, boff; int gbase, gcnt; };
struct GemmDesc { const bf16_t* A; const bf16_t* Bt; int lda, ldb, K; const int* list; };

struct DenseSched {
    int nM, nN, nwg, G, c; unsigned a_pm, a_pn, b_pn;
    __device__ void init(int M, int N, int G_, int c_, int lda, int ldb, unsigned a_pn_bytes) { nM = M / BM; nN = N / BM; nwg = nM * nN; G = G_; c = c_; a_pm = (unsigned)BM * lda * 2; a_pn = a_pn_bytes; b_pn = (unsigned)BM * ldb * 2; }
    __device__ __forceinline__ bool next(int i, Unit& u) const {
        const long L = (long)i * G + c; if (L >= nwg) return false;
        int wgid = (int)L; { const int q = nwg / NXCD, r = nwg % NXCD, xcd = wgid % NXCD, off = wgid / NXCD; wgid = (xcd < r ? xcd * (q + 1) : r * (q + 1) + (xcd - r) * q) + off; }
        const int nig = WGM * nN, gid = wgid / nig, fm = gid * WGM, gsz = (nM - fm) < WGM ? (nM - fm) : WGM;
        const int pm = fm + ((wgid % nig) % gsz), pn = (wgid % nig) / gsz;
        u.orow = pm * BM; u.ocol = pn * BM; u.aoff = pm * a_pm + pn * a_pn; u.boff = pn * b_pn; u.gbase = 0; u.gcnt = 0; return true;
    }
};
struct FoldSched {
    int G, c;
    __device__ __forceinline__ bool next(int i, Unit& u) const {
        const int L = i * G + c; if (L >= 32) return false;
        const int jl = L >> 4, g = (L >> 2) & 3, pm = L & 3;
        u.orow = jl * 1024 + pm * 256; u.ocol = g * 256; u.aoff = (unsigned)((jl * 1024 + pm * 256) * 1024 + g * 256) * 2u; u.boff = (unsigned)(jl * 4 + g) * 131072u; u.gbase = 0; u.gcnt = 0; return true;
    }
};
struct MoeSched {
    int G, c, ng, x, slot, nslots, mode, f8;
    int cnt_v, tiles_v, tb_v;
    __device__ void init(const unsigned* cnt, int G_, int c_, int mode_, int f8_ = 0) {
        G = G_; c = c_; mode = mode_; f8 = f8_; ng = (G % 8 == 0) ? 8 : 1; x = c % ng; slot = c / ng; nslots = G / ng;
        const int lane = tid_opaque() & 63;
        int cn = 0; if (lane < 32) cn = (int)__hip_atomic_load(cnt + lane * 16, __ATOMIC_RELAXED, __HIP_MEMORY_SCOPE_AGENT);
        const int tl = (cn + 255) >> 8; int v = tl;
#pragma unroll
        for (int d = 1; d < 32; d <<= 1) { const int t = lperm(lane - d, v); if (lane >= d) v += t; }
        cnt_v = cn; tiles_v = tl; tb_v = v - tl;
    }
    __device__ __forceinline__ bool next(int i, Unit& u) const {
        int v = i * nslots + slot;
        for (int e = x; e < 32; e += ng) {
            const int te = __builtin_amdgcn_readlane(tiles_v, e), ne = te * 4;
            if (v < ne) {
                const int jt = v % te, pn = v / te, tb = __builtin_amdgcn_readlane(tb_v, e), cn = __builtin_amdgcn_readlane(cnt_v, e);
                u.orow = (tb + jt) * 256; u.ocol = pn * 256;
                if (mode == 0) { u.aoff = 0; u.boff = ((unsigned)(e * 1024 + pn * 256) * 2048u) >> f8; u.gbase = e * LIST_CAP + jt * 256; u.gcnt = cn - jt * 256; }
                else { u.aoff = ((unsigned)(tb + jt) * 262144u) >> f8; u.boff = ((unsigned)(e * 1024 + pn * 256) * 1024u) >> f8; u.gbase = 0; u.gcnt = 0; }
                return true;
            }
            v -= ne;
        }
        return false;
    }
};

struct EpiAin {
    static constexpr bool PERM = true;
    bf16_t* Z; const float* bias; float* vss; const float* rstd;
    __device__ __forceinline__ void operator()(const f32x4 (&acc)[2][2][4][2], const Unit& u, int wr, int wc, int fr, int fq) const {
        const int row0 = u.orow + wr * 64 + fr, col0 = u.ocol + wc * 32 + 8 * fq; const bool vt = u.ocol >= 2048;
        f32x4 bv[2][2];
#pragma unroll
        for (int bj = 0; bj < 2; ++bj)
#pragma unroll
            for (int n = 0; n < 2; ++n) bv[bj][n] = *(const f32x4*)(bias + col0 + bj * HALF + 4 * n);
        float rsv[2][4];
#pragma unroll
        for (int ai = 0; ai < 2; ++ai)
#pragma unroll
            for (int m = 0; m < 4; ++m) rsv[ai][m] = rstd[row0 + ai * HALF + m * 16];
        if (vt) {
#pragma unroll
            for (int ai = 0; ai < 2; ++ai)
#pragma unroll
                for (int m = 0; m < 4; ++m) { const int row = row0 + ai * HALF + m * 16; bf16_t* rowp = Z + zoff(row, col0); float ss = 0.f; const float rs = rsv[ai][m];
#pragma unroll
                    for (int bj = 0; bj < 2; ++bj) { f32x4 v0 = acc[ai][bj][m][0] * rs + bv[bj][0], v1 = acc[ai][bj][m][1] * rs + bv[bj][1];
                        const f32x2 a = gelu_pk((f32x2){v0[0], v0[1]}), b = gelu_pk((f32x2){v0[2], v0[3]}), c = gelu_pk((f32x2){v1[0], v1[1]}), d = gelu_pk((f32x2){v1[2], v1[3]});
                        ss += (a.x * a.x + a.y * a.y) + (b.x * b.x + b.y * b.y) + (c.x * c.x + c.y * c.y) + (d.x * d.x + d.y * d.y);
                        u32x4 w; w.x = pk_bf16(a.x, a.y); w.y = pk_bf16(b.x, b.y); w.z = pk_bf16(c.x, c.y); w.w = pk_bf16(d.x, d.y);
                        *(u32x4*)(rowp + bj * HALF) = w; }
                    ss += lperm((fr | (fq << 4)) ^ 16, ss); ss += lperm((fr | (fq << 4)) ^ 32, ss); if (fq == 0) vss[(size_t)row * 32 + (((u.ocol - 2048) >> 8) * 4 + wc)] = ss; }
        } else {
#pragma unroll
            for (int ai = 0; ai < 2; ++ai)
#pragma unroll
                for (int m = 0; m < 4; ++m) { bf16_t* rowp = Z + zoff(row0 + ai * HALF + m * 16, col0); const float rs = rsv[ai][m];
#pragma unroll
                    for (int bj = 0; bj < 2; ++bj) { const f32x4 v0 = acc[ai][bj][m][0] * rs + bv[bj][0], v1 = acc[ai][bj][m][1] * rs + bv[bj][1];
                        u32x4 w; w.x = pk_bf16(v0[0], v0[1]); w.y = pk_bf16(v0[2], v0[3]); w.z = pk_bf16(v1[0], v1[1]); w.w = pk_bf16(v1[2], v1[3]);
                        *(u32x4*)(rowp + bj * HALF) = w; } }
        }
    }
};
struct EpiResid {
    static constexpr bool PERM = true;
    bf16_t* XB; float* xss;
    __device__ __forceinline__ void operator()(const f32x4 (&acc)[2][2][4][2], const Unit& u, int wr, int wc, int fr, int fq) const {
        const int row0 = u.orow + wr * 64 + fr, col0 = u.ocol + wc * 32 + 8 * fq;
#pragma unroll
        for (int ai = 0; ai < 2; ++ai) {
            __builtin_amdgcn_sched_barrier(0);
            u32x4 res[4][2];
#pragma unroll
            for (int m = 0; m < 4; ++m) { const bf16_t* inp = XB + (size_t)(row0 + ai * HALF + m * 16) * 1024 + col0;
#pragma unroll
                for (int bj = 0; bj < 2; ++bj) res[m][bj] = *(const u32x4*)(inp + bj * HALF); }
#pragma unroll
            for (int m = 0; m < 4; ++m) { const int row = row0 + ai * HALF + m * 16; bf16_t* rowp = XB + (size_t)row * 1024 + col0; float ss = 0.f;
#pragma unroll
                for (int bj = 0; bj < 2; ++bj) { const u32x4 r = res[m][bj]; const f32x4 a0 = acc[ai][bj][m][0], a1 = acc[ai][bj][m][1];
                    u32x4 w; w.x = pk_bf16(bf_lo(r.x) + a0[0], bf_hi(r.x) + a0[1]); w.y = pk_bf16(bf_lo(r.y) + a0[2], bf_hi(r.y) + a0[3]);
                    w.z = pk_bf16(bf_lo(r.z) + a1[0], bf_hi(r.z) + a1[1]); w.w = pk_bf16(bf_lo(r.w) + a1[2], bf_hi(r.w) + a1[3]);
                    *(u32x4*)(rowp + bj * HALF) = w;
                    const float v0 = bf_lo(w.x), v1 = bf_hi(w.x), v2 = bf_lo(w.y), v3 = bf_hi(w.y), v4 = bf_lo(w.z), v5 = bf_hi(w.z), v6 = bf_lo(w.w), v7 = bf_hi(w.w);
                    ss += ((v0 * v0 + v1 * v1) + (v2 * v2 + v3 * v3)) + ((v4 * v4 + v5 * v5) + (v6 * v6 + v7 * v7)); }
                ss += lperm((fr | (fq << 4)) ^ 16, ss); ss += lperm((fr | (fq << 4)) ^ 32, ss);
                if (fq == 0) xss[(size_t)row * 16 + (u.ocol >> 8) * 4 + wc] = ss; }
        }
    }
};
struct EpiBf {
    static constexpr bool PERM = true;
    bf16_t* O; int ldc; const float* scale; const float* rowscale;
    float cs = 1.0f;
    __device__ __forceinline__ void operator()(const f32x4 (&acc)[2][2][4][2], const Unit& u, int wr, int wc, int fr, int fq) const {
        const int row0 = u.orow + wr * 64 + fr, col0 = u.ocol + wc * 32 + 8 * fq;
        float rsv[2][4];
#pragma unroll
        for (int ai = 0; ai < 2; ++ai)
#pragma unroll
            for (int m = 0; m < 4; ++m) rsv[ai][m] = (rowscale ? rowscale[row0 + ai * HALF + m * 16] : 1.0f) * cs;
#pragma unroll
        for (int ai = 0; ai < 2; ++ai)
#pragma unroll
            for (int m = 0; m < 4; ++m) { bf16_t* rowp = O + (size_t)(row0 + ai * HALF + m * 16) * ldc + col0;
                asm volatile("" ::: "memory");
                const float rs = rsv[ai][m];
#pragma unroll
                for (int bj = 0; bj < 2; ++bj) { f32x4 v0 = acc[ai][bj][m][0] * rs, v1 = acc[ai][bj][m][1] * rs;
                    if (scale) { v0 = v0 * *(const f32x4*)(scale + col0 + bj * HALF); v1 = v1 * *(const f32x4*)(scale + col0 + bj * HALF + 4); }
                    u32x4 w; w.x = pk_bf16(v0[0], v0[1]); w.y = pk_bf16(v0[2], v0[3]); w.z = pk_bf16(v1[0], v1[1]); w.w = pk_bf16(v1[2], v1[3]);
                    *(u32x4*)(rowp + bj * HALF) = w; } }
    }
};
struct EpiY8 {
    static constexpr bool PERM = true;
    bf16_t* O; float cs;
    __device__ __forceinline__ void operator()(const f32x4 (&acc)[2][2][4][2], const Unit& u, int wr, int wc, int, int) const {
        int z = 0; asm volatile("" : "+v"(z));
        const int ln = (int)__builtin_amdgcn_mbcnt_hi(~0u, __builtin_amdgcn_mbcnt_lo(~0u, (unsigned)z)), fr = ln & 15, fq = ln >> 4;
        bf16_t* base = O + (size_t)(u.orow + wr * 64 + fr) * 1024 + u.ocol + wc * 32 + 8 * fq;
#pragma unroll
        for (int ai = 0; ai < 2; ++ai)
#pragma unroll
            for (int m = 0; m < 4; ++m) { bf16_t* rowp = base + (size_t)(ai * HALF + m * 16) * 1024;
#pragma unroll
                for (int bj = 0; bj < 2; ++bj) { const f32x4 v0 = acc[ai][bj][m][0] * cs, v1 = acc[ai][bj][m][1] * cs;
#if F8_Y
                    u32x2 w8; w8.x = pk_fp8x4(v0[0] * F8_OSC, v0[1] * F8_OSC, v0[2] * F8_OSC, v0[3] * F8_OSC); w8.y = pk_fp8x4(v1[0] * F8_OSC, v1[1] * F8_OSC, v1[2] * F8_OSC, v1[3] * F8_OSC);
                    *(u32x2*)((unsigned char*)O + (size_t)(u.orow + wr * 64 + fr + ai * HALF + m * 16) * 1024 + u.ocol + wc * 32 + 8 * fq + bj * HALF) = w8; } }
#else
                    u32x4 w; w.x = pk_bf16(v0[0], v0[1]); w.y = pk_bf16(v0[2], v0[3]); w.z = pk_bf16(v1[0], v1[1]); w.w = pk_bf16(v1[2], v1[3]);
                    *(u32x4*)(rowp + bj * HALF) = w; } }
#endif
    }
};
struct EpiSwiglu8 {
    static constexpr bool PERM = true;
    unsigned char* HID8; float cin;
    __device__ __forceinline__ void operator()(const f32x4 (&acc)[2][2][4][2], const Unit& u, int wr, int wc, int, int) const {
        int z = 0; asm volatile("" : "+v"(z));
        const int ln = (int)__builtin_amdgcn_mbcnt_hi(~0u, __builtin_amdgcn_mbcnt_lo(~0u, (unsigned)z)), fr = ln & 15, fq = ln >> 4;
        const int row0 = u.orow + wr * 64 + fr, col0 = (u.ocol >> 1) + wc * 32 + 8 * fq, ri0 = wr * 64 + fr;
#pragma unroll
        for (int ai = 0; ai < 2; ++ai)
#pragma unroll
            for (int m = 0; m < 4; ++m) { const int idx = ri0 + ai * HALF + m * 16; const float r = idx < u.gcnt ? cin : 0.f;
                unsigned char* rowp = HID8 + (size_t)(row0 + ai * HALF + m * 16) * 512 + col0;
                const f32x4 g0 = acc[ai][0][m][0] * r, g1 = acc[ai][0][m][1] * r, u0 = acc[ai][1][m][0] * (r * F8_HSC), u1 = acc[ai][1][m][1] * (r * F8_HSC);
                u32x2 w; w.x = pk_fp8x4(silu_f(g0[0]) * u0[0], silu_f(g0[1]) * u0[1], silu_f(g0[2]) * u0[2], silu_f(g0[3]) * u0[3]);
                w.y = pk_fp8x4(silu_f(g1[0]) * u1[0], silu_f(g1[1]) * u1[1], silu_f(g1[2]) * u1[2], silu_f(g1[3]) * u1[3]);
                *(u32x2*)rowp = w; }
    }
};
struct EpiSwiglu {
    static constexpr bool PERM = true;
    bf16_t* HID; const float* rss;
    __device__ __forceinline__ void operator()(const f32x4 (&acc)[2][2][4][2], const Unit& u, int wr, int wc, int fr, int fq) const {
        const int row0 = u.orow + wr * 64 + fr, col0 = (u.ocol >> 1) + wc * 32 + 8 * fq, ri0 = wr * 64 + fr;
        float rs[2][4];
#pragma unroll
        for (int ai = 0; ai < 2; ++ai)
#pragma unroll
            for (int m = 0; m < 4; ++m) { const int idx = ri0 + ai * HALF + m * 16; rs[ai][m] = idx < u.gcnt ? rss[u.gbase + idx] : 0.f; }
#pragma unroll
        for (int ai = 0; ai < 2; ++ai)
#pragma unroll
            for (int m = 0; m < 4; ++m) { bf16_t* rowp = HID + (size_t)(row0 + ai * HALF + m * 16) * 512 + col0; const float r = rs[ai][m];
                const f32x4 g0 = acc[ai][0][m][0] * r, g1 = acc[ai][0][m][1] * r, u0 = acc[ai][1][m][0] * r, u1 = acc[ai][1][m][1] * r;
                u32x4 w; w.x = pk_bf16(silu_f(g0[0]) * u0[0], silu_f(g0[1]) * u0[1]); w.y = pk_bf16(silu_f(g0[2]) * u0[2], silu_f(g0[3]) * u0[3]);
                w.z = pk_bf16(silu_f(g1[0]) * u1[0], silu_f(g1[1]) * u1[1]); w.w = pk_bf16(silu_f(g1[2]) * u1[2], silu_f(g1[3]) * u1[3]);
                *(u32x4*)rowp = w; }
    }
};

typedef long i64_t;
typedef i64_t i64x2 __attribute__((ext_vector_type(2)));
template <class Epi, class Sched, bool GATHER, bool F8 = false>
__device__ __forceinline__ void gemm_phase(LAS unsigned char* lds, const GemmDesc g, const Sched& S, const Epi& E) {
    const int tid = tid_opaque(), wid = __builtin_amdgcn_readfirstlane(tid >> 6), lane = tid & 63, wr = wid >> 2, wc = wid & 3, fr = lane & 15, fq = lane >> 4;
    const int K = g.K, nt = K / BK;
    unsigned voffB[2];
#pragma unroll
    for (int i = 0; i < 2; ++i) { int R, C; stage_rc(tid * 16 + i * 8192, R, C); const int Rb = Epi::PERM ? ((R & ~31) + perm32(R & 31)) : R; voffB[i] = (unsigned)(Rb * g.ldb + C) * 2u; }
    const size_t kstep = (size_t)(BK * 2);
    const size_t hstepB = (size_t)HALF * g.ldb * 2;
    const unsigned ldsw = (unsigned)wid * 1024u;
    const int aoff = lds_byte(wr * 64 + fr, fq * 8), boff = lds_byte(wc * 32 + fr, fq * 8);
    auto setA = [&](unsigned (&v)[2][2], const Unit& u) {
#pragma unroll
        for (int i = 0; i < 2; ++i) { int R, C; stage_rc(tid * 16 + i * 8192, R, C);
#pragma unroll
            for (int h = 0; h < 2; ++h) { const int idx = h * HALF + R;
                if constexpr (GATHER) { const int tok = idx < u.gcnt ? g.list[u.gbase + idx] : 0; v[h][i] = ((unsigned)tok * (unsigned)g.lda + (unsigned)C) * 2u; }
                else v[h][i] = ((unsigned)idx * (unsigned)g.lda + (unsigned)C) * 2u; } }
    };
#define PG_SA(b, h) (((b) * 2 + (h)) * HTB)
#define PG_SB(b, h) ((4 + (b) * 2 + (h)) * HTB)
#define PG_STAGE(bufoff, gbase, voff) do { _Pragma("unroll") for (int _i = 0; _i < 2; ++_i) \
        __builtin_amdgcn_global_load_lds((const unsigned*)((const char*)(gbase) + (voff)[_i]), (LAS unsigned*)(lds + (bufoff) + ldsw + _i * 8192), 16, 0, 0); } while (0)
#define PG_LDA(dst, b, h) do { _Pragma("unroll") for (int m = 0; m < 4; ++m) _Pragma("unroll") for (int k = 0; k < 2; ++k) dst[m][k] = *(const LAS bf16x8*)(lds + PG_SA(b, h) + aoff + m * 2048 + k * 1024); } while (0)
#define PG_LDB(dst, b, h) do { _Pragma("unroll") for (int n = 0; n < 2; ++n) _Pragma("unroll") for (int k = 0; k < 2; ++k) dst[n][k] = *(const LAS bf16x8*)(lds + PG_SB(b, h) + boff + n * 2048 + k * 1024); } while (0)
#define PG_MMA(ai, bj, At, Bt) do { __builtin_amdgcn_s_setprio(1); _Pragma("unroll") for (int m = 0; m < 4; ++m) _Pragma("unroll") for (int n = 0; n < 2; ++n) _Pragma("unroll") for (int k = 0; k < 2; ++k) { \
        if constexpr (F8) { const i64x2 _b = __builtin_bit_cast(i64x2, Bt[n][k]), _a = __builtin_bit_cast(i64x2, At[m][k]); \
            acc[ai][bj][m][n] = __builtin_amdgcn_mfma_f32_16x16x32_fp8_fp8(_b.x, _a.x, acc[ai][bj][m][n], 0, 0, 0); \
            acc[ai][bj][m][n] = __builtin_amdgcn_mfma_f32_16x16x32_fp8_fp8(_b.y, _a.y, acc[ai][bj][m][n], 0, 0, 0); } \
        else acc[ai][bj][m][n] = __builtin_amdgcn_mfma_f32_16x16x32_bf16(Bt[n][k], At[m][k], acc[ai][bj][m][n], 0, 0, 0); } __builtin_amdgcn_s_setprio(0); } while (0)
#define PG_WAIT_V(n) asm volatile("s_waitcnt vmcnt(" #n ")" ::: "memory")
#define PG_WAIT_L(n) asm volatile("s_waitcnt lgkmcnt(" #n ")" ::: "memory")
#define PG_BAR __builtin_amdgcn_s_barrier()
#define PG_SCHED __builtin_amdgcn_sched_barrier(0)
    Unit cur, nxt; int ui = 0;
    if (!S.next(0, cur)) return;
    f32x4 acc[2][2][4][2];
#pragma unroll
    for (int a = 0; a < 2; ++a)
#pragma unroll
        for (int b = 0; b < 2; ++b)
#pragma unroll
            for (int m = 0; m < 4; ++m)
#pragma unroll
                for (int n = 0; n < 2; ++n) acc[a][b][m][n] = (f32x4){0.f, 0.f, 0.f, 0.f};
    bf16x8 At[4][2], B0[2][2], B1[2][2];
    unsigned va[2][2];
    setA(va, cur);
    const char* cA = (const char*)g.A + cur.aoff; const char* cB = (const char*)g.Bt + cur.boff;
    PG_STAGE(PG_SB(0, 0), cB, voffB); PG_STAGE(PG_SB(0, 1), cB + hstepB, voffB); PG_STAGE(PG_SA(0, 0), cA, va[0]); PG_STAGE(PG_SA(0, 1), cA, va[1]);
    if (wr == 1) PG_BAR;
    PG_WAIT_V(2); PG_BAR;
    PG_STAGE(PG_SB(1, 0), cB + kstep, voffB); PG_STAGE(PG_SA(1, 0), cA + kstep, va[0]); PG_STAGE(PG_SB(1, 1), cB + hstepB + kstep, voffB);
    PG_WAIT_V(6); PG_BAR;
    for (;;) {
        const bool has_next = S.next(ui + 1, nxt);
        const char* nA = has_next ? (const char*)g.A + nxt.aoff : cA; const char* nB = has_next ? (const char*)g.Bt + nxt.boff : cB;
        for (int t = 0; t < nt; t += 2) {
            const bool last = (t == nt - 2);
            const char* a1 = cA + (size_t)(t + 1) * kstep;
            const char* a2 = last ? nA : cA + (size_t)(t + 2) * kstep; const char* b2 = last ? nB : cB + (size_t)(t + 2) * kstep;
            const char* a3 = a2 + kstep; const char* b3 = b2 + kstep;
            PG_LDB(B0, 0, 0); PG_LDB(B1, 0, 1); PG_SCHED; PG_LDA(At, 0, 0); PG_STAGE(PG_SA(1, 1), a1, va[1]);
            PG_WAIT_V(8); PG_WAIT_L(0); PG_BAR; PG_MMA(0, 0, At, B0); PG_MMA(0, 1, At, B1); PG_BAR; PG_SCHED;
            if constexpr (GATHER) { if (last && has_next) setA(va, nxt); }
            PG_LDA(At, 0, 1); PG_STAGE(PG_SB(0, 0), b2, voffB); PG_STAGE(PG_SB(0, 1), b2 + hstepB, voffB); PG_STAGE(PG_SA(0, 0), a2, va[0]);
            PG_WAIT_V(8); PG_WAIT_L(0); PG_BAR; PG_MMA(1, 0, At, B0); PG_MMA(1, 1, At, B1); PG_BAR; PG_SCHED;
            PG_LDB(B0, 1, 0); PG_LDB(B1, 1, 1); PG_SCHED; PG_LDA(At, 1, 0); PG_STAGE(PG_SA(0, 1), a2, va[1]);
            PG_WAIT_V(8); PG_WAIT_L(0); PG_BAR; PG_MMA(0, 0, At, B0); PG_MMA(0, 1, At, B1); PG_BAR; PG_SCHED;
            PG_LDA(At, 1, 1); PG_STAGE(PG_SB(1, 0), b3, voffB); PG_STAGE(PG_SB(1, 1), b3 + hstepB, voffB); PG_STAGE(PG_SA(1, 0), a3, va[0]);
            PG_WAIT_V(8); PG_WAIT_L(0); PG_BAR; PG_MMA(1, 0, At, B0); PG_MMA(1, 1, At, B1); PG_BAR; PG_SCHED;
        }
        if (wr == 0) PG_BAR;
        E(acc, cur, wr, wc, fr, fq);
        if (!has_next) break;
#pragma unroll
        for (int a = 0; a < 2; ++a)
#pragma unroll
            for (int b = 0; b < 2; ++b)
#pragma unroll
                for (int m = 0; m < 4; ++m)
#pragma unroll
                    for (int n = 0; n < 2; ++n) acc[a][b][m][n] = (f32x4){0.f, 0.f, 0.f, 0.f};
        cur = nxt; cA = nA; cB = nB; ++ui;
        if (wr == 1) PG_BAR;
    }
    PG_WAIT_V(0);
    PG_BAR;
#undef PG_SA
#undef PG_SB
#undef PG_STAGE
#undef PG_LDA
#undef PG_LDB
#undef PG_MMA
#undef PG_WAIT_V
#undef PG_WAIT_L
#undef PG_BAR
#undef PG_SCHED
}

#define XB_TMO      128
#define XB_XCNT(j)  (256  + 64 * (j))
#define XB_XSUB(j)  (1280 + 64 * (j))
#define XB_XGEN(j)  (2304 + 64 * (j))
#define XB_TOP      3328
#define XB_TOPGEN   3392
#define XCD_BAR_WORDS 3456
#define XB_SPIN_CAP (1u << 22)
__device__ __forceinline__ unsigned xb_ld(unsigned* p)              { return __hip_atomic_load(p, __ATOMIC_RELAXED, __HIP_MEMORY_SCOPE_AGENT); }
__device__ __forceinline__ unsigned xb_add(unsigned* p, unsigned v) { return __hip_atomic_fetch_add(p, v, __ATOMIC_RELAXED, __HIP_MEMORY_SCOPE_AGENT); }
__device__ __forceinline__ unsigned xb_xcc_id() { return (unsigned)__builtin_amdgcn_s_getreg((3 << 11) | 20) & 0xFu; }
#define XB_SPIN(cond, bar) do { unsigned _sp = 0; while (cond) { __builtin_amdgcn_s_sleep(1); \
    if ((++_sp & 255u) == 0u) { if (xb_ld(&(bar)[XB_TMO])) break; if (_sp > XB_SPIN_CAP) { atomicAdd(&(bar)[XB_TMO], 1u); break; } } } } while (0)
struct XcdBarrier { unsigned* bar; unsigned x; volatile LAS unsigned* st; };
__device__ __forceinline__ XcdBarrier xcd_barrier_post(unsigned* bar, volatile LAS unsigned* st) {
    XcdBarrier b; b.bar = bar; b.x = xb_xcc_id(); b.st = st;
    if (tid_opaque() == 0) (void)xb_add(&bar[XB_XCNT(b.x)], 1u);
    return b;
}
__device__ __forceinline__ void xcd_barrier_complete(unsigned* bar, unsigned x, unsigned& nloc, unsigned& nx) {
    const unsigned G = gridDim.x * gridDim.y * gridDim.z;
    unsigned sum, cnt, mine, sp = 0u;
    for (;;) {
        sum = 0u; cnt = 0u; mine = 0u;
#pragma unroll
        for (unsigned j = 0; j < 16; ++j) { const unsigned c = xb_ld(&bar[XB_XCNT(j)]); sum += c; cnt += (c > 0u) ? 1u : 0u; mine = (j == x) ? c : mine; }
        if (sum == G) break;
        __builtin_amdgcn_s_sleep(1);
        if ((++sp & 255u) == 0u) { if (xb_ld(&bar[XB_TMO])) break; if (sp > XB_SPIN_CAP) { atomicAdd(&bar[XB_TMO], 1u); break; } }
    }
    nloc = mine > 0u ? mine : 1u; nx = cnt > 0u ? cnt : 1u;
}
__device__ __forceinline__ void xcd_barrier(const XcdBarrier& b) {
    asm volatile("s_waitcnt vmcnt(0)" ::: "memory");
    __syncthreads();
    if (tid_opaque() == 0) {
        unsigned* bar = b.bar;
        __builtin_amdgcn_s_waitcnt(0);
        unsigned nloc = b.st[0], nx = b.st[1];
        if (nloc == 0u) { xcd_barrier_complete(bar, b.x, nloc, nx); b.st[0] = nloc; b.st[1] = nx; }
        const unsigned old = xb_add(&bar[XB_XSUB(b.x)], 1u);
        const unsigned gen = old / nloc;
        if (old + 1u == (gen + 1u) * nloc) {
            __builtin_amdgcn_fence(__ATOMIC_RELEASE, "agent");
            asm volatile("s_waitcnt vmcnt(0)" ::: "memory");
            const unsigned og = xb_add(&bar[XB_TOP], 1u);
            const unsigned tg = og / nx;
            if (og + 1u == (tg + 1u) * nx) xb_add(&bar[XB_TOPGEN], 1u);
            else XB_SPIN(xb_ld(&bar[XB_TOPGEN]) == tg, bar);
            __builtin_amdgcn_fence(__ATOMIC_ACQUIRE, "agent");
            xb_add(&bar[XB_XGEN(b.x)], 1u);
            asm volatile("s_waitcnt vmcnt(0)" ::: "memory");
        } else {
            XB_SPIN(xb_ld(&bar[XB_XGEN(b.x)]) == gen, bar);
            __builtin_amdgcn_fence(__ATOMIC_ACQUIRE, "agent");
            asm volatile("s_waitcnt vmcnt(0)" ::: "memory");
        }
    }
    __syncthreads();
}

__device__ __forceinline__ void row_load_f32(const float* rowp, int lane, float (&v)[16]) {
#pragma unroll
    for (int k = 0; k < 2; ++k) { const f32x4 a = *(const f32x4*)(rowp + 512 * k + 8 * lane), b = *(const f32x4*)(rowp + 512 * k + 8 * lane + 4);
#pragma unroll
        for (int j = 0; j < 4; ++j) { v[8 * k + j] = a[j]; v[8 * k + 4 + j] = b[j]; } }
}
__device__ __forceinline__ void row_store_f32(float* rowp, int lane, const float (&v)[16]) {
#pragma unroll
    for (int k = 0; k < 2; ++k) { *(f32x4*)(rowp + 512 * k + 8 * lane) = (f32x4){v[8 * k], v[8 * k + 1], v[8 * k + 2], v[8 * k + 3]}; *(f32x4*)(rowp + 512 * k + 8 * lane + 4) = (f32x4){v[8 * k + 4], v[8 * k + 5], v[8 * k + 6], v[8 * k + 7]}; }
}
__device__ __forceinline__ void row_store_bf16(bf16_t* rowp, int lane, const float (&v)[16]) {
#pragma unroll
    for (int k = 0; k < 2; ++k) { u32x4 w; w.x = pk_bf16(v[8 * k], v[8 * k + 1]); w.y = pk_bf16(v[8 * k + 2], v[8 * k + 3]); w.z = pk_bf16(v[8 * k + 4], v[8 * k + 5]); w.w = pk_bf16(v[8 * k + 6], v[8 * k + 7]);
        *(u32x4*)(rowp + 512 * k + 8 * lane) = w; }
}
__device__ __forceinline__ void row_load_bf16(const bf16_t* rowp, int lane, float (&v)[16]) {
#pragma unroll
    for (int k = 0; k < 2; ++k) { const u32x4 w = *(const u32x4*)(rowp + 512 * k + 8 * lane);
        v[8 * k] = bf_lo(w.x); v[8 * k + 1] = bf_hi(w.x); v[8 * k + 2] = bf_lo(w.y); v[8 * k + 3] = bf_hi(w.y); v[8 * k + 4] = bf_lo(w.z); v[8 * k + 5] = bf_hi(w.z); v[8 * k + 6] = bf_lo(w.w); v[8 * k + 7] = bf_hi(w.w); }
}
__device__ __forceinline__ void row_rmsnorm(const float (&x)[16], const float* g, int lane, float (&o)[16]) {
    float ss = 0.f;
#pragma unroll
    for (int j = 0; j < 16; ++j) ss += x[j] * x[j];
    ss = wave_sum(ss, lane);
    const float rstd = rsqrtf(ss * (1.0f / 1024.0f) + EPS);
    float gv[16]; row_load_f32(g, lane, gv);
#pragma unroll
    for (int j = 0; j < 16; ++j) o[j] = x[j] * rstd * gv[j];
}

struct CvtJob { const float* src; bf16_t* dst; const float* kscale; int N, K, f8; };
constexpr int NT_AIN = 2048, NT_AOUT = 1024, NT_BIN = 512, NT_BOUT = 512, NT_G = 16384, NT_U = 16384, NT_D = 16384;
constexpr int NT_TOTAL = NT_AIN + NT_AOUT + NT_BIN + NT_BOUT + NT_G + NT_U + NT_D;
__device__ __forceinline__ void cvt_decode(KP p, int r, CvtJob& jb) {
    unsigned char* ws = p->ws; const float* src; int N, K; bf16_t* dst; int tk, tn, drow; jb.kscale = nullptr; jb.f8 = 0; unsigned char* d8 = nullptr;
    if (r < NT_AIN) { const int m = r >> 10, q = r & 1023; K = 1024; N = 4096; tk = q >> 6; tn = q & 63; src = p->in[3] + (size_t)m * K * N; dst = (bf16_t*)(ws + OFF_WAIN) + (size_t)m * N * K; drow = tn * 64; jb.kscale = p->in[1] + (2 * m) * 1024 + tk * 64; }
    else if ((r -= NT_AIN) < NT_AOUT) { const int m = r >> 9, q = r & 511; K = 2048; N = 1024; tk = q >> 4; tn = q & 15; src = p->in[8] + (size_t)m * K * N; dst = (bf16_t*)(ws + OFF_WAOUT) + (size_t)m * N * K; drow = tn * 64; }
    else if ((r -= NT_AOUT) < NT_BIN) { const int m = r >> 8, q = r & 255; K = 1024; N = 1024; tk = q >> 4; tn = q & 15; src = p->in[9] + (size_t)m * K * N; dst = (bf16_t*)(ws + OFF_WBIN) + (size_t)m * N * K; drow = tn * 64; jb.kscale = p->in[1] + (2 * m + 1) * 1024 + tk * 64; }
    else if ((r -= NT_BIN) < NT_BOUT) { const int m = r >> 8, q = r & 255; K = 1024; N = 1024; tk = q >> 4; tn = q & 15; src = p->in[12] + (size_t)m * K * N; dst = (bf16_t*)(ws + OFF_WBT) + (size_t)m * N * K; drow = tn * 64; }
    else if ((r -= NT_BOUT) < NT_G + NT_U) { const int up = r >= NT_G; if (up) r -= NT_G; const int m = r >> 7, q = r & 127; K = 1024; N = 512; tk = q >> 3; tn = q & 7;
        src = p->in[up ? 18 : 17] + (size_t)m * K * N; dst = (bf16_t*)(ws + OFF_WGU) + (size_t)m * 1024 * 1024; const int n0 = tn * 64; drow = (n0 >> 7) * 256 + (n0 & 127) + (up ? 128 : 0); jb.kscale = p->in[2] + (m >> 5) * 1024 + tk * 64;
        if ((F8_LAYERS >> (m >> 5)) & 1) { jb.f8 = 1; d8 = ws + OFF_WGU + (size_t)(m >> 5) * (64u << 20) + (size_t)(m & 31) * (1u << 20) + (size_t)drow * 1024 + tk * 64; } }
    else { r -= NT_G + NT_U; const int m = r >> 7, q = r & 127; K = 512; N = 1024; tk = q >> 4; tn = q & 15; src = p->in[19] + (size_t)m * K * N; dst = (bf16_t*)(ws + OFF_WDN) + (size_t)m * N * K; drow = tn * 64;
        if ((F8_LAYERS >> (m >> 5)) & 1) { jb.f8 = 1; d8 = ws + OFF_WDN + (size_t)(m >> 5) * (32u << 20) + (size_t)(m & 31) * (512u << 10) + (size_t)drow * 512 + tk * 64; } }
    jb.src = src + (size_t)(tk * 64) * N + tn * 64; jb.dst = jb.f8 ? (bf16_t*)d8 : dst + (size_t)drow * K + tk * 64; jb.N = N; jb.K = K;
}
__device__ void phase_prep(LAS unsigned char* lds, KP p, int c, int G) {
    const int tid = tid_opaque();
    const int n4 = tid & 15, kp = tid >> 4, rn = tid >> 3, cc = tid & 7;
    constexpr int NB = 4;
    CvtJob cur[NB], nxt[NB]; f32x4 a[NB], b[NB], na[NB], nb[NB];
    float k0 = 1.f, k1 = 1.f, nk0 = 1.f, nk1 = 1.f;
#pragma unroll
    for (int q = 0; q < NB; ++q) { const int t = c * NB + q; if (t < NT_TOTAL) { cvt_decode(p, t, cur[q]); a[q] = __builtin_nontemporal_load((const f32x4*)(cur[q].src + (size_t)(2 * kp) * cur[q].N + 4 * n4)); b[q] = __builtin_nontemporal_load((const f32x4*)(cur[q].src + (size_t)(2 * kp + 1) * cur[q].N + 4 * n4)); } }
    if (c * NB < NT_TOTAL && cur[0].kscale) { k0 = cur[0].kscale[2 * kp]; k1 = cur[0].kscale[2 * kp + 1]; }
    int buf = 0;
    for (int t0 = c * NB; t0 < NT_TOTAL; t0 += NB * G) {
#pragma unroll
        for (int q = 0; q < NB; ++q) if (t0 + q < NT_TOTAL) {
            LAS unsigned* L = (LAS unsigned*)(lds + (buf * NB + q) * 8704);
            const f32x4 av = a[q] * k0, bv = b[q] * k1;
#pragma unroll
            for (int jj = 0; jj < 4; ++jj) L[(4 * n4 + jj) * 33 + kp] = pk_bf16(av[jj], bv[jj]); }
        nk0 = 1.f; nk1 = 1.f;
#pragma unroll
        for (int q = 0; q < NB; ++q) { const int t = t0 + NB * G + q; if (t < NT_TOTAL) { cvt_decode(p, t, nxt[q]); na[q] = __builtin_nontemporal_load((const f32x4*)(nxt[q].src + (size_t)(2 * kp) * nxt[q].N + 4 * n4)); nb[q] = __builtin_nontemporal_load((const f32x4*)(nxt[q].src + (size_t)(2 * kp + 1) * nxt[q].N + 4 * n4)); } }
        if (t0 + NB * G < NT_TOTAL && nxt[0].kscale) { nk0 = nxt[0].kscale[2 * kp]; nk1 = nxt[0].kscale[2 * kp + 1]; }
        __syncthreads();
#pragma unroll
        for (int q = 0; q < NB; ++q) if (t0 + q < NT_TOTAL) {
            LAS unsigned* L = (LAS unsigned*)(lds + (buf * NB + q) * 8704);
            u32x4 w; w.x = L[rn * 33 + 4 * cc]; w.y = L[rn * 33 + 4 * cc + 1]; w.z = L[rn * 33 + 4 * cc + 2]; w.w = L[rn * 33 + 4 * cc + 3];
            if (cur[q].f8) { u32x2 b8; b8.x = pk_fp8x4(bf_lo(w.x) * F8_WSC, bf_hi(w.x) * F8_WSC, bf_lo(w.y) * F8_WSC, bf_hi(w.y) * F8_WSC); b8.y = pk_fp8x4(bf_lo(w.z) * F8_WSC, bf_hi(w.z) * F8_WSC, bf_lo(w.w) * F8_WSC, bf_hi(w.w) * F8_WSC);
                __builtin_nontemporal_store(b8, (u32x2*)((unsigned char*)cur[q].dst + (size_t)rn * cur[q].K + 8 * cc)); }
            else __builtin_nontemporal_store(w, (u32x4*)(cur[q].dst + (size_t)rn * cur[q].K + 8 * cc)); }
#pragma unroll
        for (int q = 0; q < NB; ++q) { cur[q] = nxt[q]; a[q] = na[q]; b[q] = nb[q]; }
        k0 = nk0; k1 = nk1;
        buf ^= 1;
    }
    { bf16_t* wbg = (bf16_t*)(p->ws + OFF_WBG);
      for (int i = c * NTHREADS + tid; i < 2 * 4 * 256 * 256 / 4; i += G * NTHREADS) {
          const int m4 = (i & 63) * 4, jg = i >> 14;
          const f32x4 w = *(const f32x4*)(p->in[10] + (size_t)i * 4), s = *(const f32x4*)(p->in[11] + jg * 256 + m4);
          u32x2 o; o.x = pk_bf16(w[0] * s[0], w[1] * s[1]); o.y = pk_bf16(w[2] * s[2], w[3] * s[3]);
          *(u32x2*)(wbg + (size_t)i * 4) = o; } }
    const int wid = __builtin_amdgcn_readfirstlane(tid >> 6), lane = tid & 63;
    bf16_t* XB0 = (bf16_t*)(p->ws + OFF_XB); float* rstd_arr = (float*)(p->ws + OFF_RSTD); const float* xin = p->in[0];
    const int nwaves = G * 8, rpw = (T_ + nwaves - 1) / nwaves;
    const int w0 = (c * 8 + wid) * rpw; int nr = T_ - w0; nr = nr > rpw ? rpw : nr;
    if (nr > 0) {
        float x[16], xn[16]; row_load_f32(xin + (size_t)w0 * 1024, lane, x);
        for (int r = 0; r < nr; ++r) {
            const int row = w0 + r;
            if (r + 1 < nr) row_load_f32(xin + (size_t)(row + 1) * 1024, lane, xn);
            row_store_bf16(XB0 + (size_t)row * 1024, lane, x);
            float ss = 0.f;
#pragma unroll
            for (int jj = 0; jj < 16; ++jj) ss += x[jj] * x[jj];
            ss = wave_sum(ss, lane);
            const float rstd = rsqrtf(ss * (1.0f / 1024.0f) + EPS);
            if (lane == 0) rstd_arr[row] = rstd;
#pragma unroll
            for (int jj = 0; jj < 16; ++jj) x[jj] = xn[jj];
        }
    }
}

constexpr int SP_WL = 0, SP_WPITCH = 272, SP_VL = 128 * SP_WPITCH, SP_VPITCH = 528, SP_RS = SP_VL + 128 * SP_VPITCH;
__device__ void phase_spatial(LAS unsigned char* lds, KP p, int j, int c, int G) {
    const int tid = tid_opaque(), wid = tid >> 6, lane = tid & 63, fr = lane & 15, fq = lane >> 4;
    const bf16_t* Z = (const bf16_t*)(p->ws + OFF_Z); bf16_t* YS = (bf16_t*)(p->ws + OFF_YS);
    const float* Ws = p->in[6] + (size_t)j * 8 * 128 * 128; const float* bs = p->in[7] + j * 8 * 128; const float* gv = p->in[5] + j * 2048; const float* vss = (const float*)(p->ws + OFF_VSS) + (size_t)j * T_ * 32;
    LAS float* RS = (LAS float*)(lds + SP_RS);
    const int dw = wid * 32;
    int wh = -1; u32x4 vreg[8]; f32x4 wreg[8]; f32x4 sreg[2];
    float bsr[8]; f32x4 g0, g1;
#pragma unroll
    for (int jt = 0; jt < 8; ++jt) bsr[jt] = 0.f;
    g0 = (f32x4){0.f, 0.f, 0.f, 0.f}; g1 = g0;
    u32x4 ureg[8];
    auto issue = [&](int unit) {
        const int h = unit & 7, bcn = unit >> 3, row0 = bcn * 128;
        { const f32x4* vp = (const f32x4*)(vss + (size_t)(row0 + (tid >> 2)) * 32 + (tid & 3) * 8); sreg[0] = vp[0]; sreg[1] = vp[1]; }
#pragma unroll
        for (int it = 0; it < 8; ++it) { const int r = it * 16 + (tid >> 5), ch = tid & 31; vreg[it] = __builtin_nontemporal_load((const u32x4*)(Z + ((size_t)(bcn * 16 + 8 + h) * 128 + r) * 256 + ch * 8)); }
        if (h != wh) { wh = h; const int t = tid >> 2, s0 = (tid & 3) * 32; const float* wp = Ws + ((size_t)h * 128 + t) * 128 + s0;
#pragma unroll
          for (int q = 0; q < 8; ++q) wreg[q] = *(const f32x4*)(wp + 4 * q);
#pragma unroll
          for (int jt = 0; jt < 8; ++jt) bsr[jt] = bs[h * 128 + 16 * jt + fr];
          g0 = *(const f32x4*)(gv + h * 256 + dw + 8 * fq); g1 = *(const f32x4*)(gv + h * 256 + dw + 8 * fq + 4); }
    };
    auto issue_u = [&](int unit, int hf) {
        const int h = unit & 7, bcn = unit >> 3;
#pragma unroll
        for (int jj = 0; jj < 4; ++jj) { const int jt = 4 * hf + jj; ureg[jt] = __builtin_nontemporal_load((const u32x4*)(Z + ((size_t)(bcn * 16 + h) * 128 + 16 * jt + fr) * 256 + dw + 8 * fq)); }
    };
    if (c < 2048) { issue(c); issue_u(c, 0); issue_u(c, 1); }
    for (int unit = c; unit < 2048; unit += G) {
        const int h = unit & 7, bc = unit >> 3, row0 = bc * 128;
        const int colb = h * 256 + dw + 8 * fq;
        { float s = ((sreg[0][0] + sreg[0][1]) + (sreg[0][2] + sreg[0][3])) + ((sreg[1][0] + sreg[1][1]) + (sreg[1][2] + sreg[1][3]));
          s += lperm((tid & 63) ^ 1, s); s += lperm((tid & 63) ^ 2, s);
          if ((tid & 3) == 0) RS[tid >> 2] = rsqrtf(s * (1.0f / 2048.0f) + EPS); }
#pragma unroll
        for (int it = 0; it < 8; ++it) { const int r = it * 16 + (tid >> 5), ch = tid & 31; *(LAS u32x4*)(lds + SP_VL + r * SP_VPITCH + ch * 16) = vreg[it]; }
        __syncthreads();
        { const int t = tid >> 2, s0 = (tid & 3) * 32;
#pragma unroll
          for (int q = 0; q < 4; ++q) { const f32x4 a = wreg[2 * q], b = wreg[2 * q + 1]; const int s = s0 + 8 * q;
              u32x4 w; w.x = pk_bf16(a[0] * RS[s], a[1] * RS[s + 1]); w.y = pk_bf16(a[2] * RS[s + 2], a[3] * RS[s + 3]); w.z = pk_bf16(b[0] * RS[s + 4], b[1] * RS[s + 5]); w.w = pk_bf16(b[2] * RS[s + 6], b[3] * RS[s + 7]);
              *(LAS u32x4*)(lds + SP_WL + t * SP_WPITCH + s * 2) = w; } }
        __syncthreads();
        if (unit + G < 2048) issue(unit + G);
        const int li = lane & 15, q = li >> 2, pp = li & 3;
        const LAS unsigned char* vbase = lds + SP_VL + (8 * fq + q) * SP_VPITCH + (dw + 8 * pp) * 2;
        const LAS unsigned char* wbase = lds + SP_WL + fr * SP_WPITCH + (8 * fq) * 2;
#pragma unroll
        for (int hf = 0; hf < 2; ++hf) {
            f32x4 acc[2][4];
#pragma unroll
            for (int n = 0; n < 2; ++n)
#pragma unroll
                for (int jj = 0; jj < 4; ++jj) acc[n][jj] = (f32x4){0.f, 0.f, 0.f, 0.f};
#pragma unroll
            for (int ks = 0; ks < 4; ++ks) {
                bf16x8 af[2];
#pragma unroll
                for (int n = 0; n < 2; ++n) {
                    const s16x4 lo = __builtin_bit_cast(s16x4, __builtin_amdgcn_ds_read_tr16_b64_v4i16((LAS s16x4*)(vbase + (32 * ks) * SP_VPITCH + 8 * n)));
                    const s16x4 hi = __builtin_bit_cast(s16x4, __builtin_amdgcn_ds_read_tr16_b64_v4i16((LAS s16x4*)(vbase + (32 * ks + 4) * SP_VPITCH + 8 * n)));
                    af[n] = (bf16x8){lo[0], lo[1], lo[2], lo[3], hi[0], hi[1], hi[2], hi[3]}; }
#pragma unroll
                for (int jj = 0; jj < 4; ++jj) { const bf16x8 bfr = *(const LAS bf16x8*)(wbase + (16 * (4 * hf + jj)) * SP_WPITCH + (32 * ks) * 2);
                    acc[0][jj] = __builtin_amdgcn_mfma_f32_16x16x32_bf16(af[0], bfr, acc[0][jj], 0, 0, 0);
                    acc[1][jj] = __builtin_amdgcn_mfma_f32_16x16x32_bf16(af[1], bfr, acc[1][jj], 0, 0, 0); }
            }
#pragma unroll
            for (int jj = 0; jj < 4; ++jj) { const int jt = 4 * hf + jj, t = 16 * jt + fr, row = row0 + t; const float bsv = bsr[jt];
                const u32x4 uw = ureg[jt];
                const f32x2 ua = gelu_pk((f32x2){bf_lo(uw.x), bf_hi(uw.x)}), ub = gelu_pk((f32x2){bf_lo(uw.y), bf_hi(uw.y)}), uc = gelu_pk((f32x2){bf_lo(uw.z), bf_hi(uw.z)}), ud = gelu_pk((f32x2){bf_lo(uw.w), bf_hi(uw.w)});
                const f32x4 s0 = acc[0][jj] * g0 + bsv, s1 = acc[1][jj] * g1 + bsv;
                u32x4 w; w.x = pk_bf16(ua.x * s0[0], ua.y * s0[1]); w.y = pk_bf16(ub.x * s0[2], ub.y * s0[3]);
                w.z = pk_bf16(uc.x * s1[0], uc.y * s1[1]); w.w = pk_bf16(ud.x * s1[2], ud.y * s1[3]);
                *(u32x4*)(YS + (size_t)row * 2048 + colb) = w; }
            if (unit + G < 2048) issue_u(unit + G, hf);
        }
        __syncthreads();
    }
}

template <int GRP>
__device__ __forceinline__ void pool_item(const bf16_t* V1, bf16_t* Dp, int row0, int ch) {
    constexpr int W = 2 << GRP, HW = W / 2, NR = 8 + W - 1;
    const int t0 = row0 & (SEQ - 1);
    const bf16_t* base = V1 + (size_t)(row0 - t0) * 1024 + ch * 8;
    u32x4 buf[NR];
#pragma unroll
    for (int jj = 0; jj < NR; ++jj) { const int t = t0 - HW + jj; buf[jj] = (t >= 0 && t < SEQ) ? *(const u32x4*)(base + (size_t)t * 1024) : (u32x4){0u, 0u, 0u, 0u}; }
    float s[8];
#pragma unroll
    for (int e = 0; e < 8; ++e) s[e] = 0.f;
#pragma unroll
    for (int jj = 0; jj < W - 1; ++jj) { const u32x4 v = buf[jj];
        s[0] += bf_lo(v.x); s[1] += bf_hi(v.x); s[2] += bf_lo(v.y); s[3] += bf_hi(v.y); s[4] += bf_lo(v.z); s[5] += bf_hi(v.z); s[6] += bf_lo(v.w); s[7] += bf_hi(v.w); }
#pragma unroll
    for (int i = 0; i < 8; ++i) {
        { const u32x4 v = buf[i + W - 1];
          s[0] += bf_lo(v.x); s[1] += bf_hi(v.x); s[2] += bf_lo(v.y); s[3] += bf_hi(v.y); s[4] += bf_lo(v.z); s[5] += bf_hi(v.z); s[6] += bf_lo(v.w); s[7] += bf_hi(v.w); }
        const int t = t0 + i; int lo = t - HW, hi = t + HW; lo = lo < 0 ? 0 : lo; hi = hi > SEQ ? SEQ : hi;
        const float inv = 1.0f / (float)(hi - lo);
        const u32x4 v = buf[i + HW];
        u32x4 o; o.x = pk_bf16(s[0] * inv - bf_lo(v.x), s[1] * inv - bf_hi(v.x)); o.y = pk_bf16(s[2] * inv - bf_lo(v.y), s[3] * inv - bf_hi(v.y));
        o.z = pk_bf16(s[4] * inv - bf_lo(v.z), s[5] * inv - bf_hi(v.z)); o.w = pk_bf16(s[6] * inv - bf_lo(v.w), s[7] * inv - bf_hi(v.w));
        *(u32x4*)(Dp + (size_t)(row0 + i) * 1024 + ch * 8) = o;
        { const u32x4 q = buf[i];
          s[0] -= bf_lo(q.x); s[1] -= bf_hi(q.x); s[2] -= bf_lo(q.y); s[3] -= bf_hi(q.y); s[4] -= bf_lo(q.z); s[5] -= bf_hi(q.z); s[6] -= bf_lo(q.w); s[7] -= bf_hi(q.w); }
    }
}
__device__ void phase_pool(KP p, int c, int G) {
    const bf16_t* V1 = (const bf16_t*)(p->ws + OFF_Z); bf16_t* Dp = (bf16_t*)(p->ws + OFF_Z) + (size_t)T_ * 1024;
    const int tid = tid_opaque(), wid = __builtin_amdgcn_readfirstlane(tid >> 6), lane = tid & 63;
    for (int wi = c * 8 + wid; wi < (T_ / 16) * 4; wi += G * 8) {
        const int g = wi & 3, rp = wi >> 2;
        const int row0 = rp * 16 + (lane >> 5) * 8, ch = g * 32 + (lane & 31);
        switch (g) {
        case 0: pool_item<0>(V1, Dp, row0, ch); break;
        case 1: pool_item<1>(V1, Dp, row0, ch); break;
        case 2: pool_item<2>(V1, Dp, row0, ch); break;
        default: pool_item<3>(V1, Dp, row0, ch); break;
        }
    }
}

constexpr int RW_PITCH = 1032;
constexpr int RW_BYTES = 36 * RW_PITCH * 2;
__device__ void phase_router(LAS unsigned char* lds, KP p, int layer, int c, int G, int cset) {
    const int tid = tid_opaque(), wid = __builtin_amdgcn_readfirstlane(tid >> 6), lane = tid & 63, fr = lane & 15, fq = lane >> 4;
    LAS bf16_t* WH = (LAS bf16_t*)lds; LAS bf16_t* WL = (LAS bf16_t*)(lds + RW_BYTES);
    const float* rgw = p->in[13] + (size_t)layer * 1024 * 4; const float* rgb = p->in[14] + layer * 4;
    const float* rew = p->in[15] + (size_t)layer * 1024 * 32; const float* reb = p->in[16] + layer * 32;
    const float* xss = (const float*)(p->ws + OFF_XSS);
    u32x4 xa[16], xb[16]; f32x4 ppx = (f32x4){0.f, 0.f, 0.f, 0.f};
    const bool act0 = c * 8 + wid < T_ / 16;
    const bf16_t* xr0 = (const bf16_t*)(p->ws + OFF_XB) + (size_t)((act0 ? c * 8 + wid : 0) * 16 + fr) * 1024 + 8 * fq;
    if (act0) { ppx = *(const f32x4*)(xss + (size_t)((c * 8 + wid) * 16 + fr) * 16 + 4 * fq);
#pragma unroll
        for (int ks = 0; ks < 16; ++ks) xa[ks] = *(const u32x4*)(xr0 + 32 * ks); }
    else {
#pragma unroll
        for (int ks = 0; ks < 16; ++ks) xa[ks] = (u32x4){0u, 0u, 0u, 0u}; }
    const float* gf = p->in[2] + layer * 1024;
#pragma unroll 1
    for (int k = tid; k < 1024; k += NTHREADS) {
        const float gk = gf[k];
        const f32x4 a = *(const f32x4*)(rgw + k * 4) * gk;
#pragma unroll
        for (int jj = 0; jj < 4; ++jj) { const unsigned hi = pk_bf16(a[jj], 0.f) & 0xffffu; const float rem = a[jj] - __uint_as_float(hi << 16);
            WH[jj * RW_PITCH + k] = (bf16_t)hi; WL[jj * RW_PITCH + k] = (bf16_t)(pk_bf16(rem, 0.f) & 0xffffu); }
#pragma unroll
        for (int q = 0; q < 8; ++q) { const f32x4 b = *(const f32x4*)(rew + k * 32 + 4 * q) * gk;
#pragma unroll
            for (int jj = 0; jj < 4; ++jj) { const unsigned hi = pk_bf16(b[jj], 0.f) & 0xffffu; const float rem = b[jj] - __uint_as_float(hi << 16);
                WH[(4 + 4 * q + jj) * RW_PITCH + k] = (bf16_t)hi; WL[(4 + 4 * q + jj) * RW_PITCH + k] = (bf16_t)(pk_bf16(rem, 0.f) & 0xffffu); } }
    }
    LAS float* lbias = (LAS float*)(lds + LDS_MISC + 512);
    if (tid < 36) lbias[tid] = tid < 4 ? rgb[tid] : reb[tid - 4];
    __builtin_amdgcn_sched_barrier(0);
    if (act0) {
#pragma unroll
        for (int ks = 0; ks < 16; ++ks) xb[ks] = *(const u32x4*)(xr0 + 32 * (16 + ks)); }
    else {
#pragma unroll
        for (int ks = 0; ks < 16; ++ks) xb[ks] = (u32x4){0u, 0u, 0u, 0u}; }
    __syncthreads();
    float* rss = (float*)(p->ws + OFF_RSS);
    unsigned* cnt = (unsigned*)(p->ws + OFF_CTL) + CW_CNT + cset * 32 * 16;
    int* list = (int*)(p->ws + OFF_LIST); i32x4* slot = (i32x4*)(p->ws + OFF_SLOT); f32x2* gates = (f32x2*)(p->ws + OFF_GATE);
    LAS unsigned* lcnt = (LAS unsigned*)(lds + LDS_MISC + 64); LAS unsigned* lbase = lcnt + 32;
    int wrow[3];
#pragma unroll
    for (int t = 0; t < 3; ++t) { const int o = 16 * t + fr; wrow[t] = (o < 36 ? o : 35) * RW_PITCH + 8 * fq; }
    for (int cb = c * 8; cb < T_ / 16; cb += G * 8) {
        const int ch = cb + wid; const bool active = ch < T_ / 16;
        if (tid < 32) lcnt[tid] = 0u;
        __syncthreads();
        const int row = (active ? ch : 0) * 16 + fr;
        int e0 = 0, e1 = 0, k0 = 0, k1 = 0; float gt0 = 0.f, gt1 = 0.f, rstd_row = 0.f;
        if (active) {
            if (cb != c * 8) { const bf16_t* xr = (const bf16_t*)(p->ws + OFF_XB) + (size_t)row * 1024 + 8 * fq;
                ppx = *(const f32x4*)(xss + (size_t)row * 16 + 4 * fq);
#pragma unroll
                for (int ks = 0; ks < 16; ++ks) { xa[ks] = *(const u32x4*)(xr + 32 * ks); xb[ks] = *(const u32x4*)(xr + 32 * (16 + ks)); } }
            float ss = (ppx[0] + ppx[1]) + (ppx[2] + ppx[3]);
            ss += lperm(lane ^ 16, ss); ss += lperm(lane ^ 32, ss);
            const float rstd = rsqrtf(ss * (1.0f / 1024.0f) + EPS); rstd_row = rstd;
            if ((F8_LAYERS >> layer) & 1) {
                unsigned char* xq = p->ws + OFF_H + (size_t)row * 1024 + 8 * fq; const float sc = rstd * F8_XSC;
#pragma unroll
                for (int ks = 0; ks < 32; ++ks) { const u32x4 xw = ks < 16 ? xa[ks & 15] : xb[ks & 15];
                    u32x2 b8; b8.x = pk_fp8x4(bf_lo(xw.x) * sc, bf_hi(xw.x) * sc, bf_lo(xw.y) * sc, bf_hi(xw.y) * sc); b8.y = pk_fp8x4(bf_lo(xw.z) * sc, bf_hi(xw.z) * sc, bf_lo(xw.w) * sc, bf_hi(xw.w) * sc);
                    *(u32x2*)(xq + 32 * ks) = b8; } }
            f32x4 acc[3];
            const LAS bf16_t* whp[3]; const LAS bf16_t* wlp[3];
#pragma unroll
            for (int t = 0; t < 3; ++t) { acc[t] = (f32x4){0.f, 0.f, 0.f, 0.f}; whp[t] = WH + wrow[t]; wlp[t] = WL + wrow[t]; asm volatile("" : "+v"(whp[t]), "+v"(wlp[t])); }
#pragma unroll
            for (int ks = 0; ks < 32; ++ks) {
                const bf16x8 fh = __builtin_bit_cast(bf16x8, ks < 16 ? xa[ks & 15] : xb[ks & 15]);
#pragma unroll
                for (int t = 0; t < 3; ++t) { const bf16x8 wh = *(const LAS bf16x8*)(whp[t] + 32 * ks), wl = *(const LAS bf16x8*)(wlp[t] + 32 * ks);
                    acc[t] = __builtin_amdgcn_mfma_f32_16x16x32_bf16(wh, fh, acc[t], 0, 0, 0);
                    acc[t] = __builtin_amdgcn_mfma_f32_16x16x32_bf16(wl, fh, acc[t], 0, 0, 0); }
            }
#pragma unroll
            for (int t = 0; t < 3; ++t) acc[t] = acc[t] * rstd;
            f32x4 lg[3];
#pragma unroll
            for (int t = 0; t < 3; ++t)
#pragma unroll
                for (int r = 0; r < 4; ++r) { const int o = 16 * t + 4 * fq + r; const float b = lbias[o < 36 ? o : 35]; lg[t][r] = acc[t][r] + b; }
            float gl[4];
#pragma unroll
            for (int jj = 0; jj < 4; ++jj) gl[jj] = lperm(fr, lg[0][jj]);
            int gi = 0; float gm = gl[0];
#pragma unroll
            for (int jj = 1; jj < 4; ++jj) if (gl[jj] > gm) { gm = gl[jj]; gi = jj; }
            float gs = 0.f;
#pragma unroll
            for (int jj = 0; jj < 4; ++jj) gs += __expf(gl[jj] - gm);
            const float gw = 1.0f / gs;
            const int q1 = 1 + 2 * gi, q2 = 2 + 2 * gi, t1 = q1 >> 2, t2 = q2 >> 2;
            float el[8];
#pragma unroll
            for (int r = 0; r < 4; ++r) { const float c1 = t1 == 0 ? lg[0][r] : lg[1][r]; const float c2 = t2 == 0 ? lg[0][r] : t2 == 1 ? lg[1][r] : lg[2][r];
                el[r] = lperm(fr + 16 * (q1 & 3), c1); el[4 + r] = lperm(fr + 16 * (q2 & 3), c2); }
            int i0 = 0; float m0 = el[0];
#pragma unroll
            for (int jj = 1; jj < 8; ++jj) if (el[jj] > m0) { m0 = el[jj]; i0 = jj; }
            int i1 = -1; float m1 = -INFINITY;
#pragma unroll
            for (int jj = 0; jj < 8; ++jj) if (jj != i0 && el[jj] > m1) { m1 = el[jj]; i1 = jj; }
            const float ex = __expf(m1 - m0), w0 = 1.0f / (1.0f + ex), w1 = ex * w0;
            e0 = gi * 8 + i0; e1 = gi * 8 + i1; gt0 = gw * w0; gt1 = gw * w1;
            if (fq == 0) { k0 = (int)__hip_atomic_fetch_add(lcnt + e0, 1u, __ATOMIC_RELAXED, __HIP_MEMORY_SCOPE_WORKGROUP); k1 = (int)__hip_atomic_fetch_add(lcnt + e1, 1u, __ATOMIC_RELAXED, __HIP_MEMORY_SCOPE_WORKGROUP); }
        }
        __syncthreads();
        if (tid < 32) { const unsigned n = lcnt[tid]; lbase[tid] = n ? atomicAdd(cnt + tid * 16, n) : 0u; }
        __syncthreads();
        if (active && fq == 0) {
            const int p0 = (int)lbase[e0] + k0, p1 = (int)lbase[e1] + k1;
            list[e0 * LIST_CAP + p0] = row; list[e1 * LIST_CAP + p1] = row; rss[e0 * LIST_CAP + p0] = rstd_row; rss[e1 * LIST_CAP + p1] = rstd_row;
            slot[row] = (i32x4){e0, p0, e1, p1}; gates[row] = (f32x2){gt0, gt1};
        }
    }
}

#if F8_Y
struct CombRow { u32x4 x[2]; u32x2 y0[2], y1[2]; };
__device__ __forceinline__ void comb_load(CombRow& r, const bf16_t* xrow, const bf16_t* y0, const bf16_t* y1, int lane) {
#pragma unroll
    for (int k = 0; k < 2; ++k) { r.x[k] = *(const u32x4*)(xrow + 512 * k + 8 * lane);
        r.y0[k] = __builtin_nontemporal_load((const u32x2*)((const unsigned char*)y0 + 512 * k + 8 * lane)); r.y1[k] = __builtin_nontemporal_load((const u32x2*)((const unsigned char*)y1 + 512 * k + 8 * lane)); }
}
#else
struct CombRow { u32x4 x[2]; u32x4 y0[2], y1[2]; };
__device__ __forceinline__ void comb_load(CombRow& r, const bf16_t* xrow, const bf16_t* y0, const bf16_t* y1, int lane) {
#pragma unroll
    for (int k = 0; k < 2; ++k) { r.x[k] = *(const u32x4*)(xrow + 512 * k + 8 * lane);
        r.y0[k] = __builtin_nontemporal_load((const u32x4*)(y0 + 512 * k + 8 * lane)); r.y1[k] = __builtin_nontemporal_load((const u32x4*)(y1 + 512 * k + 8 * lane)); }
}
#endif
constexpr int YROW = F8_Y ? 512 : 1024;
__device__ void phase_combine(KP p, int layer, int c, int G, float* Xout) {
    const int tid = tid_opaque(), wid = __builtin_amdgcn_readfirstlane(tid >> 6), lane = tid & 63;
    const unsigned* cnt = (const unsigned*)(p->ws + OFF_CTL) + CW_CNT + layer * 32 * 16;
    int tb;
    { int cn = 0; if (lane < 32) cn = (int)__hip_atomic_load(cnt + lane * 16, __ATOMIC_RELAXED, __HIP_MEMORY_SCOPE_AGENT);
      const int tl = (cn + 255) >> 8; int v = tl;
#pragma unroll
      for (int d = 1; d < 32; d <<= 1) { const int t = lperm(lane - d, v); if (lane >= d) v += t; }
      tb = v - tl; }
    const bf16_t* YM = (const bf16_t*)(p->ws + OFF_Z + HID_BYTES);
    const i32x4* slot = (const i32x4*)(p->ws + OFF_SLOT); const f32x2* gates = (const f32x2*)(p->ws + OFF_GATE);
    bf16_t* X = (bf16_t*)(p->ws + OFF_XB); float* rstd_arr = (float*)(p->ws + OFF_RSTD);
    const bool last = layer == 3; const float* gn = last ? p->in[20] : p->in[1] + (layer + 1) * 1024;
    float gv[16]; row_load_f32(gn, lane, gv);
    const int nwaves = G * 8, rpw = (T_ + nwaves - 1) / nwaves;
    const int w0 = (c * 8 + wid) * rpw; int nr = T_ - w0; nr = nr > rpw ? rpw : nr;
    if (nr <= 0) return;
    int r0v = 0, r1v = 0; float g0v = 0.f, g1v = 0.f;
    { i32x4 sm = (i32x4){0, 0, 0, 0}; f32x2 gm = (f32x2){0.f, 0.f};
      if (lane < nr) { sm = slot[w0 + lane]; gm = gates[w0 + lane]; }
      r0v = lperm(sm[0], tb) * 256 + sm[1]; r1v = lperm(sm[2], tb) * 256 + sm[3]; g0v = gm.x; g1v = gm.y; }
    CombRow cur, nxt;
    comb_load(cur, X + (size_t)w0 * 1024, YM + (size_t)__builtin_amdgcn_readlane(r0v, 0) * YROW, YM + (size_t)__builtin_amdgcn_readlane(r1v, 0) * YROW, lane);
    for (int r = 0; r < nr; ++r) {
        const int row = w0 + r;
        if (r + 1 < nr) comb_load(nxt, X + (size_t)(row + 1) * 1024, YM + (size_t)__builtin_amdgcn_readlane(r0v, r + 1) * YROW, YM + (size_t)__builtin_amdgcn_readlane(r1v, r + 1) * YROW, lane);
        const float g0 = __builtin_bit_cast(float, __builtin_amdgcn_readlane(__builtin_bit_cast(int, g0v), r)), g1 = __builtin_bit_cast(float, __builtin_amdgcn_readlane(__builtin_bit_cast(int, g1v), r));
        float x[16];
#pragma unroll
#if F8_Y
        for (int k = 0; k < 2; ++k) { const u32x2 a = cur.y0[k], b = cur.y1[k]; const u32x4 xv = cur.x[k]; const float h0 = g0 * (1.0f / F8_OSC), h1 = g1 * (1.0f / F8_OSC);
            const f32x2 a0 = __builtin_amdgcn_cvt_pk_f32_fp8((int)a.x, false), a1 = __builtin_amdgcn_cvt_pk_f32_fp8((int)a.x, true), a2 = __builtin_amdgcn_cvt_pk_f32_fp8((int)a.y, false), a3 = __builtin_amdgcn_cvt_pk_f32_fp8((int)a.y, true);
            const f32x2 b0 = __builtin_amdgcn_cvt_pk_f32_fp8((int)b.x, false), b1 = __builtin_amdgcn_cvt_pk_f32_fp8((int)b.x, true), b2 = __builtin_amdgcn_cvt_pk_f32_fp8((int)b.y, false), b3 = __builtin_amdgcn_cvt_pk_f32_fp8((int)b.y, true);
            x[8 * k + 0] = bf_lo(xv.x) + h0 * a0.x + h1 * b0.x; x[8 * k + 1] = bf_hi(xv.x) + h0 * a0.y + h1 * b0.y;
            x[8 * k + 2] = bf_lo(xv.y) + h0 * a1.x + h1 * b1.x; x[8 * k + 3] = bf_hi(xv.y) + h0 * a1.y + h1 * b1.y;
            x[8 * k + 4] = bf_lo(xv.z) + h0 * a2.x + h1 * b2.x; x[8 * k + 5] = bf_hi(xv.z) + h0 * a2.y + h1 * b2.y;
            x[8 * k + 6] = bf_lo(xv.w) + h0 * a3.x + h1 * b3.x; x[8 * k + 7] = bf_hi(xv.w) + h0 * a3.y + h1 * b3.y; }
#else
        for (int k = 0; k < 2; ++k) { const u32x4 a = cur.y0[k], b = cur.y1[k], xv = cur.x[k];
            x[8 * k + 0] = bf_lo(xv.x) + g0 * bf_lo(a.x) + g1 * bf_lo(b.x); x[8 * k + 1] = bf_hi(xv.x) + g0 * bf_hi(a.x) + g1 * bf_hi(b.x);
            x[8 * k + 2] = bf_lo(xv.y) + g0 * bf_lo(a.y) + g1 * bf_lo(b.y); x[8 * k + 3] = bf_hi(xv.y) + g0 * bf_hi(a.y) + g1 * bf_hi(b.y);
            x[8 * k + 4] = bf_lo(xv.z) + g0 * bf_lo(a.z) + g1 * bf_lo(b.z); x[8 * k + 5] = bf_hi(xv.z) + g0 * bf_hi(a.z) + g1 * bf_hi(b.z);
            x[8 * k + 6] = bf_lo(xv.w) + g0 * bf_lo(a.w) + g1 * bf_lo(b.w); x[8 * k + 7] = bf_hi(xv.w) + g0 * bf_hi(a.w) + g1 * bf_hi(b.w); }
#endif
        float ss = 0.f;
#pragma unroll
        for (int jj = 0; jj < 16; ++jj) ss += x[jj] * x[jj];
        ss = wave_sum(ss, lane);
        const float rstd = rsqrtf(ss * (1.0f / 1024.0f) + EPS);
        if (last) { float o[16];
#pragma unroll
            for (int jj = 0; jj < 16; ++jj) o[jj] = x[jj] * rstd * gv[jj];
            row_store_f32(Xout + (size_t)row * 1024, lane, o); }
        else { row_store_bf16(X + (size_t)row * 1024, lane, x); if (lane == 0) rstd_arr[row] = rstd; }
        cur = nxt;
    }
}

enum { K_PREP = 0, K_A1, K_A2, K_A3, K_B1, K_B2, K_B3, K_B4, K_M1, K_M2, K_M3, K_M4 };
constexpr int NPHASES = 29;
__device__ __forceinline__ void phase_decode(int ph, int& kind, int& layer) {
    if (ph == 0) { kind = K_PREP; layer = 0; return; }
    const int q = ph - 1, pair = q / 14, off = q % 14;
    if (off < 7) { layer = 2 * pair; kind = off < 3 ? K_A1 + off : K_M1 + (off - 3); }
    else { layer = 2 * pair + 1; const int o = off - 7; kind = o == 0 ? K_B1 : o == 1 ? K_B2 : o == 2 ? K_B4 : K_M1 + (o - 3); }
}

__global__ void __launch_bounds__(NTHREADS, 2) mk(Params p_arg, int ph_lo, int ph_hi, int coop) {
    extern __shared__ __attribute__((aligned(16))) unsigned char smem[];
    LAS unsigned char* lds = (LAS unsigned char*)smem;
    volatile LAS unsigned* st = (volatile LAS unsigned*)(lds + LDS_MISC);
    { const int t0 = (int)threadIdx.x; *(volatile LAS int*)(lds + LDS_WVTAB + hw_slot() * 4) = t0 >> 6; if (t0 < 4) st[t0] = 0u; }
    __syncthreads();
    XcdBarrier bar; bar.bar = (unsigned*)(p_arg.ws + OFF_CTL); bar.x = 0; bar.st = st;
    if (ph_hi - ph_lo > 1) bar = xcd_barrier_post((unsigned*)(p_arg.ws + OFF_CTL), st);
#ifdef REP_KIND
    int rep_done = 0;
#endif
    for (int ph = ph_lo; ph < ph_hi; ++ph) {
        int kind, layer; phase_decode(ph, kind, layer);
        KP p = (KP)__builtin_amdgcn_kernarg_segment_ptr();
        int c = blockIdx.x, G = gridDim.x;
        asm volatile("" : "+s"(kind), "+s"(layer), "+s"(p), "+s"(c), "+s"(G));
        unsigned char* ws = p->ws;
        const int j = layer >> 1;
        switch (kind) {
        case K_PREP: phase_prep(lds, p, c, G); break;
        case K_A1: { GemmDesc g{(const bf16_t*)(ws + OFF_XB), (const bf16_t*)(ws + OFF_WAIN) + (size_t)j * 4096 * 1024, 1024, 1024, 1024, nullptr};
            DenseSched S; S.init(T_, 4096, G, c, 1024, 1024, 0);
            EpiAin E{(bf16_t*)(ws + OFF_Z), p->in[4] + j * 4096, (float*)(ws + OFF_VSS) + (size_t)j * T_ * 32, (const float*)(ws + OFF_RSTD)};
            gemm_phase<EpiAin, DenseSched, false>(lds, g, S, E);
            } break;
        case K_A2: phase_spatial(lds, p, j, c, G); break;
        case K_A3: { GemmDesc g{(const bf16_t*)(ws + OFF_YS), (const bf16_t*)(ws + OFF_WAOUT) + (size_t)j * 1024 * 2048, 2048, 2048, 2048, nullptr};
            DenseSched S; S.init(T_, 1024, G, c, 2048, 2048, 0);
            EpiResid E{(bf16_t*)(ws + OFF_XB), (float*)(ws + OFF_XSS)};
            gemm_phase<EpiResid, DenseSched, false>(lds, g, S, E); } break;
        case K_B1: { GemmDesc g{(const bf16_t*)(ws + OFF_XB), (const bf16_t*)(ws + OFF_WBIN) + (size_t)j * 1024 * 1024, 1024, 1024, 1024, nullptr};
            DenseSched S; S.init(T_, 1024, G, c, 1024, 1024, 0);
            EpiBf E{(bf16_t*)(ws + OFF_Z), 1024, nullptr, (const float*)(ws + OFF_RSTD)};
            gemm_phase<EpiBf, DenseSched, false>(lds, g, S, E); } break;
        case K_B2: phase_pool(p, c, G); break;
        case K_B4: { GemmDesc g{(const bf16_t*)(ws + OFF_Z) + (size_t)T_ * 1024, (const bf16_t*)(ws + OFF_WBOUT) + (size_t)j * 1024 * 1024, 1024, 1024, 1024, nullptr};
            DenseSched S; S.init(T_, 1024, G, c, 1024, 1024, 0);
            EpiResid E{(bf16_t*)(ws + OFF_XB), (float*)(ws + OFF_XSS)};
            gemm_phase<EpiResid, DenseSched, false>(lds, g, S, E); } break;
        case K_M1:
#ifdef PROBE_M1
            phase_router(lds, p, layer, c, G, layer + 4); xcd_barrier(bar);
#endif
            phase_router(lds, p, layer, c, G, layer); break;
        case K_M2: if ((F8_LAYERS >> layer) & 1) {
            GemmDesc g{(const bf16_t*)(ws + OFF_H), (const bf16_t*)(ws + OFF_WGU) + (size_t)layer * 32 * 1024 * 1024, 512, 512, 512, (const int*)(ws + OFF_LIST)};
            MoeSched S; S.init((const unsigned*)(ws + OFF_CTL) + CW_CNT + layer * 32 * 16, G, c, 0, 1);
            EpiSwiglu8 E{ws + OFF_Z, 1.0f / (F8_XSC * F8_WSC)};
            gemm_phase<EpiSwiglu8, MoeSched, true, true>(lds, g, S, E); }
          else { GemmDesc g{(const bf16_t*)(ws + OFF_XB), (const bf16_t*)(ws + OFF_WGU) + (size_t)layer * 32 * 1024 * 1024, 1024, 1024, 1024, (const int*)(ws + OFF_LIST)};
            MoeSched S; S.init((const unsigned*)(ws + OFF_CTL) + CW_CNT + layer * 32 * 16, G, c, 0);
            EpiSwiglu E{(bf16_t*)(ws + OFF_Z), (const float*)(ws + OFF_RSS)};
            gemm_phase<EpiSwiglu, MoeSched, true>(lds, g, S, E); }
            if (layer == 0) {
                const int fb = G > 32 ? G - 32 : 0;
                if (c >= fb) {
                    int kf = 256; asm volatile("" : "+s"(kf));
                    GemmDesc gf{(const bf16_t*)(ws + OFF_WBT), (const bf16_t*)(ws + OFF_WBG), 1024, 256, kf, nullptr};
                    FoldSched SF{G - fb, c - fb}; EpiBf EF{(bf16_t*)(ws + OFF_WBOUT), 1024, nullptr, nullptr};
                    gemm_phase<EpiBf, FoldSched, false>(lds, gf, SF, EF); } }
            break;
        case K_M3: if ((F8_LAYERS >> layer) & 1) {
            GemmDesc g{(const bf16_t*)(ws + OFF_Z), (const bf16_t*)(ws + OFF_WDN) + (size_t)layer * 32 * 1024 * 512, 256, 256, 256, nullptr};
            MoeSched S; S.init((const unsigned*)(ws + OFF_CTL) + CW_CNT + layer * 32 * 16, G, c, 1, 1);
            EpiY8 E{(bf16_t*)(ws + OFF_Z + HID_BYTES), 1.0f / (F8_HSC * F8_WSC)};
            gemm_phase<EpiY8, MoeSched, false, true>(lds, g, S, E); }
          else { GemmDesc g{(const bf16_t*)(ws + OFF_Z), (const bf16_t*)(ws + OFF_WDN) + (size_t)layer * 32 * 1024 * 512, 512, 512, 512, nullptr};
            MoeSched S; S.init((const unsigned*)(ws + OFF_CTL) + CW_CNT + layer * 32 * 16, G, c, 1);
            EpiBf E{(bf16_t*)(ws + OFF_Z + HID_BYTES), 1024, nullptr, nullptr};
            gemm_phase<EpiBf, MoeSched, false>(lds, g, S, E); } break;
        case K_M4:
#ifdef PROBE_M4
            phase_combine(p, layer == 3 ? 2 : layer, c, G, (float*)(ws + OFF_YS)); xcd_barrier(bar);
#endif
            phase_combine(p, layer, c, G, p->X); break;
        }
#ifdef REP_KIND
        if (kind == REP_KIND && rep_done < REP_N - 1) { ++rep_done; xcd_barrier(bar); --ph; continue; }
        rep_done = 0;
#endif
        if (ph + 1 < ph_hi) {
#if MK_CG_SYNC
            if (coop && ph == ph_lo) { cg::this_grid().sync(); } else
#endif
            xcd_barrier(bar);
        }
    }
}

extern "C" void kernel_launch(void* const* d_in, const int* in_sizes, int n_in, void* d_out, int out_size, void* d_ws, size_t ws_size, hipStream_t stream) {
    static int grid = 0;
    if (!grid) {
        if (n_in != 21 || out_size != T_ * DM || ws_size < WS_END) { fprintf(stderr, "kernel_launch: unexpected shapes (n_in %d out %d ws %zu need %zu)\n", n_in, out_size, ws_size, (size_t)WS_END); return; }
        int dev = 0, cus = 0, per_cu = 0;
        hipGetDevice(&dev); hipDeviceGetAttribute(&cus, hipDeviceAttributeMultiprocessorCount, dev);
        if (hipFuncSetAttribute((const void*)mk, hipFuncAttributeMaxDynamicSharedMemorySize, LDS_BYTES) != hipSuccess) { fprintf(stderr, "kernel_launch: hipFuncSetAttribute failed\n"); return; }
        hipOccupancyMaxActiveBlocksPerMultiprocessor(&per_cu, (const void*)mk, NTHREADS, LDS_BYTES);
        if (per_cu < 1) { fprintf(stderr, "kernel_launch: occupancy query says %d blocks per CU\n", per_cu); per_cu = 1; }
        grid = cus * 1;
        if (grid % 8) grid -= grid % 8;
    }
    hipMemsetAsync((char*)d_ws + OFF_CTL, 0, CTL_BYTES, stream);
    Params p; memset(&p, 0, sizeof(p));
    for (int i = 0; i < 21; ++i) p.in[i] = (const float*)d_in[i];
    p.X = (float*)d_out; p.ws = (unsigned char*)d_ws;
#if MK_SINGLE
    int lo = 0, hi = NPHASES, coop = 1;
    void* args[] = {&p, &lo, &hi, &coop};
    hipError_t e = hipLaunchCooperativeKernel((const void*)mk, dim3(grid), dim3(NTHREADS), args, LDS_BYTES, stream);
    if (e != hipSuccess) fprintf(stderr, "cooperative launch failed: %s (grid %d)\n", hipGetErrorString(e), grid);
#else
    for (int ph = 0; ph < NPHASES; ++ph) hipLaunchKernelGGL(mk, dim3(grid), dim3(NTHREADS), LDS_BYTES, stream, p, ph, ph + 1, 0);
#endif
}
```
